# Optimizing an MI355X kernel written in HIP

```python
import math
import jax, jax.numpy as jnp
from jax import lax
import numpy as np

D_MODEL = 1024
BATCH = 32
SEQ = 2048
DEPTH = 1
DEC_BATCH = 8
DEC_SEQ = 4096
PAST_LEN = 128

ATT_HEADS = 4
ATT_QK_DIM = 64
ATT_V_DIM = 2 * ATT_QK_DIM
ATT_WIDTH = ATT_HEADS * ATT_V_DIM
QK_WIDTH = ATT_HEADS * ATT_QK_DIM
SSM_WIDTH = D_MODEL - ATT_WIDTH
SSM_GROUP = 16
SSM_GROUPS = SSM_WIDTH // SSM_GROUP
SSM_STATE = 64
MIX_WIDTH = ATT_WIDTH + SSM_WIDTH
IN_WIDTH = 4 * QK_WIDTH + ATT_WIDTH + SSM_WIDTH
D_FF = 2816
ROPE_THETA = 10000.0
Q_BLOCK = 128
NORM_EPS = 1e-6
SUBLN_EPS = 1e-5
DT_MIN = 1e-3
DT_MAX = 1e-1

kernel_name = "hymba_diffattn_s5_macaron_encoder"


def rms_norm(x, g, eps=NORM_EPS):
    xf = x.astype(jnp.float32)
    y = xf * lax.rsqrt(jnp.mean(xf * xf, axis=-1, keepdims=True) + eps)
    return (y * g.astype(jnp.float32)).astype(x.dtype)


def swiglu(x, w_gate, w_up, w_down):
    return (jax.nn.silu(x @ w_gate) * (x @ w_up)) @ w_down


def rope(x):
    L, d = x.shape[1], x.shape[-1]
    half = d // 2
    inv_freq = ROPE_THETA ** (-jnp.arange(half, dtype=jnp.float32) / half)
    ang = jnp.arange(L, dtype=jnp.float32)[:, None] * inv_freq[None, :]
    cos = jnp.cos(ang)[None, :, None, :]
    sin = jnp.sin(ang)[None, :, None, :]
    xf = x.astype(jnp.float32)
    x1, x2 = xf[..., :half], xf[..., half:]
    out = jnp.concatenate([x1 * cos - x2 * sin, x2 * cos + x1 * sin], axis=-1)
    return out.astype(x.dtype)


def diff_attention(q1, q2, k1, k2, v, lam, sub_g, lambda_init):
    B, L, H, d = q1.shape
    nb = L // Q_BLOCK
    scale = d ** -0.5

    def to_blocks(q):
        return (q * scale).reshape(B, nb, Q_BLOCK, H, d).transpose(1, 0, 2, 3, 4)

    def one_block(qs):
        qa, qb = qs
        s1 = jnp.einsum('bqhd,bkhd->bhqk', qa, k1).astype(jnp.float32)
        s2 = jnp.einsum('bqhd,bkhd->bhqk', qb, k2).astype(jnp.float32)
        p = jax.nn.softmax(s1, axis=-1) - lam * jax.nn.softmax(s2, axis=-1)
        return jnp.einsum('bhqk,bkhe->bqhe', p.astype(v.dtype), v)

    o = lax.map(one_block, (to_blocks(q1), to_blocks(q2)))
    o = o.transpose(1, 0, 2, 3, 4).reshape(B, L, H, 2 * d)
    o = rms_norm(o, sub_g, SUBLN_EPS) * (1.0 - lambda_init)
    return o.reshape(B, L, H * 2 * d)


def _ssm_combine(e1, e2):
    a1, b1 = e1
    a2, b2 = e2
    return a1 * a2, a2 * b1 + b2


def ssm_bidir(u, a_re, a_im, log_dt, b_re, b_im, c_re, c_im, d_skip):
    uf = u.astype(jnp.float32)
    uc = uf.astype(jnp.complex64)
    y = uf * d_skip.astype(jnp.float32)
    for direction, rev in enumerate((False, True)):
        lam = lax.complex(a_re[direction].astype(jnp.float32), a_im[direction].astype(jnp.float32))
        dt = jnp.exp(log_dt[direction].astype(jnp.float32))
        lam_bar = jnp.exp(lam * dt)
        b = lax.complex(b_re[direction].astype(jnp.float32), b_im[direction].astype(jnp.float32))
        b_bar = ((lam_bar - 1.0) / lam)[..., None] * b
        bu = jnp.einsum('blgh,gph->blgp', uc, b_bar)
        a = jnp.broadcast_to(lam_bar, bu.shape)
        _, h = lax.associative_scan(_ssm_combine, (a, bu), axis=1, reverse=rev)
        c = lax.complex(c_re[direction].astype(jnp.float32), c_im[direction].astype(jnp.float32))
        y = y + jnp.real(jnp.einsum('blgp,ghp->blgh', h, c))
    return y.astype(u.dtype)


def _trunk(x, ffn1_norm, ffn1_w_gate, ffn1_w_up, ffn1_w_down, mix_norm, w_in,
           lambda_q1, lambda_k1, lambda_q2, lambda_k2, attn_sub_norm,
           ssm_a_re, ssm_a_im, ssm_log_dt, ssm_b_re, ssm_b_im, ssm_c_re, ssm_c_im,
           ssm_d, ssm_w_glu, w_out, ffn2_norm, ffn2_w_gate, ffn2_w_up, ffn2_w_down,
           final_norm):
    B, L, _ = x.shape
    for l in range(DEPTH):
        h = rms_norm(x, ffn1_norm[l])
        x = x + 0.5 * swiglu(h, ffn1_w_gate[l], ffn1_w_up[l], ffn1_w_down[l])
        h = rms_norm(x, mix_norm[l])
        proj = h @ w_in[l]
        q1, q2, k1, k2, v, u = jnp.split(
            proj, [QK_WIDTH, 2 * QK_WIDTH, 3 * QK_WIDTH, 4 * QK_WIDTH, 4 * QK_WIDTH + ATT_WIDTH], axis=-1)
        heads = lambda t: t.reshape(B, L, ATT_HEADS, ATT_QK_DIM)
        q1, q2, k1, k2 = rope(heads(q1)), rope(heads(q2)), rope(heads(k1)), rope(heads(k2))
        v = v.reshape(B, L, ATT_HEADS, ATT_V_DIM)
        lambda_init = 0.8 - 0.6 * math.exp(-0.3 * l)
        lam = (jnp.exp(jnp.sum(lambda_q1[l].astype(jnp.float32) * lambda_k1[l].astype(jnp.float32)))
               - jnp.exp(jnp.sum(lambda_q2[l].astype(jnp.float32) * lambda_k2[l].astype(jnp.float32)))
               + lambda_init)
        attn_out = diff_attention(q1, q2, k1, k2, v, lam, attn_sub_norm[l], lambda_init)
        s = ssm_bidir(u.reshape(B, L, SSM_GROUPS, SSM_GROUP), ssm_a_re[l], ssm_a_im[l], ssm_log_dt[l],
                      ssm_b_re[l], ssm_b_im[l], ssm_c_re[l], ssm_c_im[l],
                      ssm_d[l].reshape(SSM_GROUPS, SSM_GROUP)).reshape(B, L, SSM_WIDTH)
        s = jax.nn.gelu(s)
        ssm_out = s * jax.nn.sigmoid(s @ ssm_w_glu[l])
        x = x + jnp.concatenate([attn_out, ssm_out], axis=-1) @ w_out[l]
        h = rms_norm(x, ffn2_norm[l])
        x = x + 0.5 * swiglu(h, ffn2_w_gate[l], ffn2_w_up[l], ffn2_w_down[l])
    return rms_norm(x, final_norm)


def setup_inputs(seed: int = 0) -> dict:
    key = jax.random.key(seed)
    ks = iter(jax.random.split(key, 40))
    f32 = jnp.float32

    def nrm(shape, std):
        return jax.random.normal(next(ks), shape, f32) * std

    def gain(shape):
        return 1.0 + nrm(shape, 0.02)

    G, P, H = SSM_GROUPS, SSM_STATE, SSM_GROUP
    n = jnp.arange(P, dtype=f32)
    a_re = -0.5 + nrm((DEPTH, 2, G, P), 0.01)
    a_im = jnp.pi * n + nrm((DEPTH, 2, G, P), 0.01)
    log_dt = jax.random.uniform(next(ks), (DEPTH, 2, G, P), f32,
                                math.log(DT_MIN), math.log(DT_MAX))
    return {
        "x_prompt": nrm((BATCH, SEQ, D_MODEL), 1.0),
        "x_sample": nrm((DEC_BATCH, DEC_SEQ, D_MODEL), 1.0),
        "ffn1_norm": gain((DEPTH, D_MODEL)),
        "ffn1_w_gate": nrm((DEPTH, D_MODEL, D_FF), D_MODEL ** -0.5),
        "ffn1_w_up": nrm((DEPTH, D_MODEL, D_FF), D_MODEL ** -0.5),
        "ffn1_w_down": nrm((DEPTH, D_FF, D_MODEL), D_FF ** -0.5),
        "mix_norm": gain((DEPTH, D_MODEL)),
        "w_in": nrm((DEPTH, D_MODEL, IN_WIDTH), D_MODEL ** -0.5),
        "lambda_q1": nrm((DEPTH, ATT_QK_DIM), 0.1),
        "lambda_k1": nrm((DEPTH, ATT_QK_DIM), 0.1),
        "lambda_q2": nrm((DEPTH, ATT_QK_DIM), 0.1),
        "lambda_k2": nrm((DEPTH, ATT_QK_DIM), 0.1),
        "attn_sub_norm": gain((DEPTH, ATT_V_DIM)),
        "ssm_a_re": a_re,
        "ssm_a_im": a_im,
        "ssm_log_dt": log_dt,
        "ssm_b_re": nrm((DEPTH, 2, G, P, H), (2 * H) ** -0.5),
        "ssm_b_im": nrm((DEPTH, 2, G, P, H), (2 * H) ** -0.5),
        "ssm_c_re": nrm((DEPTH, 2, G, H, P), (2 * P) ** -0.5),
        "ssm_c_im": nrm((DEPTH, 2, G, H, P), (2 * P) ** -0.5),
        "ssm_d": nrm((DEPTH, SSM_WIDTH), 1.0),
        "ssm_w_glu": nrm((DEPTH, SSM_WIDTH, SSM_WIDTH), SSM_WIDTH ** -0.5),
        "w_out": nrm((DEPTH, MIX_WIDTH, D_MODEL), MIX_WIDTH ** -0.5),
        "ffn2_norm": gain((DEPTH, D_MODEL)),
        "ffn2_w_gate": nrm((DEPTH, D_MODEL, D_FF), D_MODEL ** -0.5),
        "ffn2_w_up": nrm((DEPTH, D_MODEL, D_FF), D_MODEL ** -0.5),
        "ffn2_w_down": nrm((DEPTH, D_FF, D_MODEL), D_FF ** -0.5),
        "final_norm": gain((D_MODEL,)),
    }


def reference(x_prompt, x_sample, ffn1_norm, ffn1_w_gate, ffn1_w_up, ffn1_w_down, mix_norm, w_in,
              lambda_q1, lambda_k1, lambda_q2, lambda_k2, attn_sub_norm,
              ssm_a_re, ssm_a_im, ssm_log_dt, ssm_b_re, ssm_b_im, ssm_c_re, ssm_c_im,
              ssm_d, ssm_w_glu, w_out, ffn2_norm, ffn2_w_gate, ffn2_w_up, ffn2_w_down,
              final_norm):
    params = (ffn1_norm, ffn1_w_gate, ffn1_w_up, ffn1_w_down, mix_norm, w_in,
              lambda_q1, lambda_k1, lambda_q2, lambda_k2, attn_sub_norm,
              ssm_a_re, ssm_a_im, ssm_log_dt, ssm_b_re, ssm_b_im, ssm_c_re, ssm_c_im,
              ssm_d, ssm_w_glu, w_out, ffn2_norm, ffn2_w_gate, ffn2_w_up, ffn2_w_down,
              final_norm)
    y_prompt = _trunk(x_prompt, *params)
    y_sample = _trunk(x_sample, *params)
    return (y_prompt, y_sample)
```

```cpp
#include <hip/hip_runtime.h>
#include <hip/hip_cooperative_groups.h>
#include <cstdio>
#include <cstdint>
namespace cg = cooperative_groups;

#ifndef MK_MULTI
#define MK_MULTI 0
#endif

#define LAS __attribute__((address_space(3)))
#define GAS __attribute__((address_space(1)))
typedef unsigned short bf16_t;
typedef short bf16x8 __attribute__((ext_vector_type(8)));
typedef short s16x4 __attribute__((ext_vector_type(4)));
typedef float f32x4 __attribute__((ext_vector_type(4)));
typedef float f32x2 __attribute__((ext_vector_type(2)));
typedef float f32x16 __attribute__((ext_vector_type(16)));
typedef unsigned u32x4 __attribute__((ext_vector_type(4)));
typedef unsigned u32x2 __attribute__((ext_vector_type(2)));

constexpr int DM = 1024, MP = 65536, MT = 98304, LPR = 2048, LSM = 4096, DFF = 2816;
constexpr int NCH = MT / 64;
constexpr int MG = 32 * NCH;
constexpr int LDU = 1280;
constexpr float C2 = 0.125f * 1.4426950408889634f;
constexpr float LOG2E = 1.4426950408889634f;

constexpr size_t MiB = (size_t)1 << 20;
constexpr size_t WS_XB = 0;
constexpr size_t WS_H = 192 * MiB;
constexpr size_t WS_Q12 = 192 * MiB;
constexpr size_t WS_K12 = 288 * MiB;
constexpr size_t WS_V = 384 * MiB;
constexpr size_t WS_UH = 480 * MiB;
constexpr size_t WS_S = 600 * MiB;
constexpr size_t WS_W1 = 720 * MiB, WS_W1D = 731 * MiB, WS_WIN = 737 * MiB, WS_WOUT = 741 * MiB, WS_WGLU = 743 * MiB, WS_W2 = 744 * MiB, WS_W2D = 755 * MiB;
constexpr size_t WS_SS = 761 * MiB;
constexpr size_t WS_ROPE = 767 * MiB;
constexpr size_t WS_BBAR = 768 * MiB;
constexpr size_t WS_SCAL = 769 * MiB;
constexpr size_t WS_END = 770 * MiB;
constexpr size_t DO_MIX = 0;
constexpr size_t DO_BTY = 192 * MiB;
constexpr size_t DO_WSM = 272 * MiB;
constexpr size_t DO_LPOW = 288 * MiB;
constexpr size_t DO_KK = 292 * MiB;

#define LDS_WAIT() asm volatile("s_waitcnt lgkmcnt(0)" ::: "memory")
#define VM_WAIT() asm volatile("s_waitcnt vmcnt(0)" ::: "memory")
#define MEMFENCE() asm volatile("" ::: "memory")

__device__ __forceinline__ int tidx() { int t = threadIdx.x; asm volatile("" : "+v"(t)); return t; }
__device__ __forceinline__ unsigned cvt_pk_bf16(float lo, float hi) { unsigned r; asm volatile("v_cvt_pk_bf16_f32 %0, %1, %2" : "=v"(r) : "v"(lo), "v"(hi)); return r; }
__device__ __forceinline__ float bf_lo(unsigned w) { return __uint_as_float(w << 16); }
__device__ __forceinline__ float bf_hi(unsigned w) { return __uint_as_float(w & 0xffff0000u); }
__device__ __forceinline__ float fast_rcp(float x) { return __builtin_amdgcn_rcpf(x); }
__device__ __forceinline__ float fast_exp2(float x) { return __builtin_amdgcn_exp2f(x); }
__device__ __forceinline__ float rinv_of(const float* ss, int row) {
    const f32x4* p = (const f32x4*)(ss + (size_t)row * 16);
    const f32x4 a = p[0], b = p[1], c = p[2], d = p[3];
    const float s = ((a.x + a.y) + (a.z + a.w)) + ((b.x + b.y) + (b.z + b.w)) + ((c.x + c.y) + (c.z + c.w)) + ((d.x + d.y) + (d.z + d.w));
    return rsqrtf(s * (1.0f / 1024.0f) + 1e-6f);
}

namespace pg8 {
constexpr int BM = 256, BK = 64, HALF = 128, HTB = HALF * BK * 2, STAGE_BYTES = 8 * HTB, NXCD = 8, WGM = 8;
__host__ __device__ __forceinline__ int lds_byte(int r, int c) { const int st = (r >> 4) * 2 + (c >> 5), rr = r & 15, cc = c & 31, ob = rr * 64 + cc * 2; return st * 1024 + (ob ^ (((ob >> 9) & 1) << 5)); }
__host__ __device__ __forceinline__ void stage_rc(int b, int& R, int& C) { const int st = b / 1024, sb = b % 1024, swz = sb ^ (((sb >> 9) & 1) << 5); R = (st >> 1) * 16 + swz / 64; C = (st & 1) * 32 + (swz % 64) / 2; }
__host__ __device__ __forceinline__ int perm32(int rho) { const int n = rho >> 4, i = rho & 15; return 8 * (i >> 2) + 4 * n + (i & 3); }
struct Unit { int pm, pn; };
struct Gemm { const bf16_t* A; const bf16_t* Bt; int M, N, K, lda, ldb, gdiv, gtiles; };
struct StaticOrder {
    int nM, nN, nwg, G, c;
    __device__ void init(int M, int N, int G_, int c_) { nM = M / BM; nN = N / BM; nwg = nM * nN; G = G_; c = c_; }
    __device__ bool next(int i, Unit& u) const {
        const long L = (long)i * G + c; if (L >= nwg) return false;
        int wgid = (int)L; { const int q = nwg / NXCD, r = nwg % NXCD, xcd = wgid % NXCD, off = wgid / NXCD; wgid = (xcd < r ? xcd * (q + 1) : r * (q + 1) + (xcd - r) * q) + off; }
        const int nig = WGM * nN, gid = wgid / nig, fm = gid * WGM, gsz = (nM - fm) < WGM ? (nM - fm) : WGM;
        u.pm = fm + ((wgid % nig) % gsz); u.pn = (wgid % nig) / gsz; return true;
    }
};
template <class Epi>
__device__ __forceinline__ void gemm_phase(LAS unsigned char* lds, const Gemm g, const StaticOrder& S, const Epi& E) {
    const int tid = tidx(), wid = __builtin_amdgcn_readfirstlane(tid >> 6), lane = tid & 63, wr = wid >> 2, wc = wid & 3, fr = lane & 15, fq = lane >> 4;
    const int K = g.K, nt = K / BK;
    unsigned voffA[2], voffB[2];
#pragma unroll
    for (int i = 0; i < 2; ++i) { int R, C; stage_rc(tid * 16 + i * 8192, R, C); const int Rb = (R & ~31) + perm32(R & 31);
        voffA[i] = (unsigned)(R * g.lda + C) * 2u; voffB[i] = (unsigned)(Rb * g.ldb + C) * 2u; }
    const size_t kstep = (size_t)(BK * 2);
    const size_t hstepA = (size_t)HALF * g.lda * 2, hstepB = (size_t)HALF * g.ldb * 2;
    const size_t tstepA = 2 * hstepA, tstepB = 2 * hstepB;
    const unsigned ldsw = (unsigned)wid * 1024u;
    const int aoff = lds_byte(wr * 64 + fr, fq * 8), boff = lds_byte(wc * 32 + fr, fq * 8);
#define PG8_BT(u) ((u).pn + (g.gdiv ? ((u).pm / g.gdiv) * g.gtiles : 0))
#define PG8_SA(b, h) (((b) * 2 + (h)) * HTB)
#define PG8_SB(b, h) ((4 + (b) * 2 + (h)) * HTB)
#define PG8_STAGE(bufoff, gbase, voff) do { _Pragma("unroll") for (int _i = 0; _i < 2; ++_i) \
        __builtin_amdgcn_global_load_lds((const unsigned*)((const char*)(gbase) + (voff)[_i]), (LAS unsigned*)(lds + (bufoff) + ldsw + _i * 8192), 16, 0, 0); } while (0)
#define PG8_LDA(dst, b, h) do { _Pragma("unroll") for (int m = 0; m < 4; ++m) _Pragma("unroll") for (int k = 0; k < 2; ++k) dst[m][k] = *(const LAS bf16x8*)(lds + PG8_SA(b, h) + aoff + m * 2048 + k * 1024); } while (0)
#define PG8_LDB(dst, b, h) do { _Pragma("unroll") for (int n = 0; n < 2; ++n) _Pragma("unroll") for (int k = 0; k < 2; ++k) dst[n][k] = *(const LAS bf16x8*)(lds + PG8_SB(b, h) + boff + n * 2048 + k * 1024); } while (0)
#define PG8_MMA(ai, bj, At, Bt) do { __builtin_amdgcn_s_setprio(1); _Pragma("unroll") for (int m = 0; m < 4; ++m) _Pragma("unroll") for (int n = 0; n < 2; ++n) _Pragma("unroll") for (int k = 0; k < 2; ++k) \
        acc[ai][bj][m][n] = __builtin_amdgcn_mfma_f32_16x16x32_bf16(Bt[n][k], At[m][k], acc[ai][bj][m][n], 0, 0, 0); __builtin_amdgcn_s_setprio(0); } while (0)
#define PG8_WAIT_V(n) asm volatile("s_waitcnt vmcnt(" #n ")" ::: "memory")
#define PG8_WAIT_L(n) asm volatile("s_waitcnt lgkmcnt(" #n ")" ::: "memory")
#define PG8_BAR __builtin_amdgcn_s_barrier()
#define PG8_SCHED __builtin_amdgcn_sched_barrier(0)
    Unit cur, nxt; int ui = 0;
    if (!S.next(0, cur)) return;
    f32x4 acc[2][2][4][2];
#pragma unroll
    for (int a = 0; a < 2; ++a)
#pragma unroll
        for (int b = 0; b < 2; ++b)
#pragma unroll
            for (int m = 0; m < 4; ++m)
#pragma unroll
                for (int n = 0; n < 2; ++n) acc[a][b][m][n] = (f32x4){0.f, 0.f, 0.f, 0.f};
    bf16x8 At[4][2], B0[2][2], B1[2][2];
    const char* cA = (const char*)g.A + (size_t)cur.pm * tstepA; const char* cB = (const char*)g.Bt + (size_t)PG8_BT(cur) * tstepB;
    PG8_STAGE(PG8_SB(0, 0), cB, voffB); PG8_STAGE(PG8_SB(0, 1), cB + hstepB, voffB); PG8_STAGE(PG8_SA(0, 0), cA, voffA); PG8_STAGE(PG8_SA(0, 1), cA + hstepA, voffA);
    if (wr == 1) PG8_BAR;
    PG8_WAIT_V(2); PG8_BAR;
    PG8_STAGE(PG8_SB(1, 0), cB + kstep, voffB); PG8_STAGE(PG8_SA(1, 0), cA + kstep, voffA); PG8_STAGE(PG8_SB(1, 1), cB + hstepB + kstep, voffB);
    PG8_WAIT_V(6); PG8_BAR;
    for (;;) {
        const bool has_next = S.next(ui + 1, nxt);
        const char* nA = has_next ? (const char*)g.A + (size_t)nxt.pm * tstepA : cA; const char* nB = has_next ? (const char*)g.Bt + (size_t)PG8_BT(nxt) * tstepB : cB;
        for (int t = 0; t < nt; t += 2) {
            const bool last = (t == nt - 2);
            const char* a1 = cA + (size_t)(t + 1) * kstep;
            const char* a2 = last ? nA : cA + (size_t)(t + 2) * kstep; const char* b2 = last ? nB : cB + (size_t)(t + 2) * kstep;
            const char* a3 = a2 + kstep; const char* b3 = b2 + kstep;
            PG8_LDB(B0, 0, 0); PG8_LDB(B1, 0, 1); PG8_SCHED; PG8_LDA(At, 0, 0); PG8_STAGE(PG8_SA(1, 1), a1 + hstepA, voffA);
            PG8_WAIT_V(8); PG8_WAIT_L(0); PG8_BAR; PG8_MMA(0, 0, At, B0); PG8_MMA(0, 1, At, B1); PG8_BAR; PG8_SCHED;
            PG8_LDA(At, 0, 1); PG8_STAGE(PG8_SB(0, 0), b2, voffB); PG8_STAGE(PG8_SB(0, 1), b2 + hstepB, voffB); PG8_STAGE(PG8_SA(0, 0), a2, voffA);
            PG8_WAIT_V(8); PG8_WAIT_L(0); PG8_BAR; PG8_MMA(1, 0, At, B0); PG8_MMA(1, 1, At, B1); PG8_BAR; PG8_SCHED;
            PG8_LDB(B0, 1, 0); PG8_LDB(B1, 1, 1); PG8_SCHED; PG8_LDA(At, 1, 0); PG8_STAGE(PG8_SA(0, 1), a2 + hstepA, voffA);
            PG8_WAIT_V(8); PG8_WAIT_L(0); PG8_BAR; PG8_MMA(0, 0, At, B0); PG8_MMA(0, 1, At, B1); PG8_BAR; PG8_SCHED;
            PG8_LDA(At, 1, 1); PG8_STAGE(PG8_SB(1, 0), b3, voffB); PG8_STAGE(PG8_SB(1, 1), b3 + hstepB, voffB); PG8_STAGE(PG8_SA(1, 0), a3, voffA);
            PG8_WAIT_V(8); PG8_WAIT_L(0); PG8_BAR; PG8_MMA(1, 0, At, B0); PG8_MMA(1, 1, At, B1); PG8_BAR; PG8_SCHED;
        }
        if (wr == 0) PG8_BAR;
        E(acc, cur, wr, wc, fr, fq);
        if (!has_next) break;
#pragma unroll
        for (int a = 0; a < 2; ++a)
#pragma unroll
            for (int b = 0; b < 2; ++b)
#pragma unroll
                for (int m = 0; m < 4; ++m)
#pragma unroll
                    for (int n = 0; n < 2; ++n) acc[a][b][m][n] = (f32x4){0.f, 0.f, 0.f, 0.f};
        cur = nxt; cA = nA; cB = nB; ++ui;
        if (wr == 1) PG8_BAR;
    }
    PG8_WAIT_V(0);
    PG8_BAR;
#undef PG8_BT
#undef PG8_SA
#undef PG8_SB
#undef PG8_STAGE
#undef PG8_LDA
#undef PG8_LDB
#undef PG8_MMA
#undef PG8_WAIT_V
#undef PG8_WAIT_L
#undef PG8_BAR
#undef PG8_SCHED
}

typedef f32x4 Acc[2][2][4][2];

struct EpiSwiGLU {
    bf16_t* H; const float* ss;
    __device__ __forceinline__ void operator()(const Acc& acc, const Unit& u, int wr, int wc, int fr, int fq) const {
        const int row0 = u.pm * BM + wr * 64 + fr, col0 = u.pn * 128 + wc * 32 + 8 * fq;
#pragma unroll
        for (int ai = 0; ai < 2; ++ai)
#pragma unroll
            for (int m = 0; m < 4; ++m) {
                const int row = row0 + ai * HALF + m * 16; const float ri = rinv_of(ss, row);
                float hv[8];
#pragma unroll
                for (int n = 0; n < 2; ++n)
#pragma unroll
                    for (int j = 0; j < 4; ++j) { const float gt = acc[ai][0][m][n][j] * ri, up = acc[ai][1][m][n][j] * ri;
                        hv[n * 4 + j] = gt * up * fast_rcp(1.0f + fast_exp2(-gt * LOG2E)); }
                u32x4 w; w.x = cvt_pk_bf16(hv[0], hv[1]); w.y = cvt_pk_bf16(hv[2], hv[3]); w.z = cvt_pk_bf16(hv[4], hv[5]); w.w = cvt_pk_bf16(hv[6], hv[7]);
                *(u32x4*)(H + (size_t)row * DFF + col0) = w;
                if (m & 1) MEMFENCE();
            }
    }
};
struct EpiRes {
    const float* baseP; const float* baseS; const bf16_t* base16; float alpha; float* out32; bf16_t* out16; float* ss;
    __device__ __forceinline__ void operator()(const Acc& acc, const Unit& u, int wr, int wc, int fr, int fq) const {
        const int row0 = u.pm * BM + wr * 64 + fr;
#pragma unroll
        for (int ai = 0; ai < 2; ++ai)
#pragma unroll
            for (int m = 0; m < 4; ++m) {
                const int row = row0 + ai * HALF + m * 16; float sq = 0.f;
#pragma unroll
                for (int bj = 0; bj < 2; ++bj) {
                    const int col = u.pn * BM + bj * HALF + wc * 32 + 8 * fq; const size_t off = (size_t)row * DM + col;
                    f32x4 b0, b1;
                    if (base16) { const u32x4 w = *(const u32x4*)(base16 + off); b0 = (f32x4){bf_lo(w.x), bf_hi(w.x), bf_lo(w.y), bf_hi(w.y)}; b1 = (f32x4){bf_lo(w.z), bf_hi(w.z), bf_lo(w.w), bf_hi(w.w)}; }
                    else { const GAS float* bp = (u.pm < MP / BM) ? (const GAS float*)baseP + off : (const GAS float*)baseS + (off - (size_t)MP * DM); b0 = *(const GAS f32x4*)bp; b1 = *(const GAS f32x4*)(bp + 4); }
                    const f32x4 v0 = b0 + acc[ai][bj][m][0] * alpha, v1 = b1 + acc[ai][bj][m][1] * alpha;
                    sq += (v0.x * v0.x + v0.y * v0.y) + (v0.z * v0.z + v0.w * v0.w) + (v1.x * v1.x + v1.y * v1.y) + (v1.z * v1.z + v1.w * v1.w);
                    if (out32) { *(f32x4*)(out32 + off) = v0; *(f32x4*)(out32 + off + 4) = v1; }
                    if (out16) { u32x4 w; w.x = cvt_pk_bf16(v0.x, v0.y); w.y = cvt_pk_bf16(v0.z, v0.w); w.z = cvt_pk_bf16(v1.x, v1.y); w.w = cvt_pk_bf16(v1.z, v1.w); *(u32x4*)(out16 + off) = w; }
                }
                if (ss) { sq += __shfl_xor(sq, 16); sq += __shfl_xor(sq, 32); if (fq == 0) ss[(size_t)row * 16 + u.pn * 4 + wc] = sq; }
                if (m & 1) MEMFENCE();
            }
    }
};
struct EpiProj {
    const float* ss; const f32x4* rope; bf16_t *Q12, *K12, *V, *UH;
    __device__ __forceinline__ void operator()(const Acc& acc, const Unit& u, int wr, int wc, int fr, int fq) const {
        const int row0 = u.pm * BM + wr * 64 + fr; const int pn = u.pn;
#pragma unroll
        for (int ai = 0; ai < 2; ++ai)
#pragma unroll
            for (int m = 0; m < 4; ++m) {
                const int row = row0 + ai * HALF + m * 16; const float ri = rinv_of(ss, row);
                if (pn < 4) {
                    const int pos = row < MP ? (row & (LPR - 1)) : ((row - MP) & (LSM - 1));
                    const f32x4* rp = rope + ((size_t)pos * 32 + 8 * fq) / 2;
                    const float sc = (pn < 2 ? C2 : 1.0f) * ri;
                    float o1[8], o2[8];
#pragma unroll
                    for (int q = 0; q < 4; ++q) { const f32x4 cs = rp[q];
                        { const int e = 2 * q; const float x1 = acc[ai][0][m][e >> 2][e & 3] * sc, x2 = acc[ai][1][m][e >> 2][e & 3] * sc; o1[e] = x1 * cs.x - x2 * cs.y; o2[e] = x2 * cs.x + x1 * cs.y; }
                        { const int e = 2 * q + 1; const float x1 = acc[ai][0][m][e >> 2][e & 3] * sc, x2 = acc[ai][1][m][e >> 2][e & 3] * sc; o1[e] = x1 * cs.z - x2 * cs.w; o2[e] = x2 * cs.z + x1 * cs.w; } }
                    bf16_t* dst = (pn < 2 ? Q12 : K12) + (size_t)row * 512 + (pn & 1) * 256 + wc * 64 + 8 * fq;
                    u32x4 w; w.x = cvt_pk_bf16(o1[0], o1[1]); w.y = cvt_pk_bf16(o1[2], o1[3]); w.z = cvt_pk_bf16(o1[4], o1[5]); w.w = cvt_pk_bf16(o1[6], o1[7]); *(u32x4*)dst = w;
                    w.x = cvt_pk_bf16(o2[0], o2[1]); w.y = cvt_pk_bf16(o2[2], o2[3]); w.z = cvt_pk_bf16(o2[4], o2[5]); w.w = cvt_pk_bf16(o2[6], o2[7]); *(u32x4*)(dst + 32) = w;
                } else {
#pragma unroll
                    for (int bj = 0; bj < 2; ++bj) {
                        const f32x4 v0 = acc[ai][bj][m][0] * ri, v1 = acc[ai][bj][m][1] * ri;
                        u32x4 w; w.x = cvt_pk_bf16(v0.x, v0.y); w.y = cvt_pk_bf16(v0.z, v0.w); w.z = cvt_pk_bf16(v1.x, v1.y); w.w = cvt_pk_bf16(v1.z, v1.w);
                        const int c0 = (pn & 1) * 256 + bj * HALF + wc * 32 + 8 * fq;
                        if (pn < 6) *(u32x4*)(V + (size_t)row * 512 + c0) = w;
                        else { const int gq = c0 >> 4, hi0 = c0 & 15; *(u32x4*)(UH + ((size_t)gq * NCH + (row >> 6)) * LDU + (row & 63) * 16 + hi0) = w; }
                    }
                }
                if (m & 1) MEMFENCE();
            }
    }
};
struct EpiS {
    float* S;
    __device__ __forceinline__ void operator()(const Acc& acc, const Unit& u, int wr, int wc, int fr, int fq) const {
        const int row0 = u.pm * BM + wr * 64 + fr;
#pragma unroll
        for (int ai = 0; ai < 2; ++ai)
#pragma unroll
            for (int m = 0; m < 4; ++m) { const int row = row0 + ai * HALF + m * 16;
#pragma unroll
                for (int bj = 0; bj < 2; ++bj) { float* p = S + (size_t)row * 256 + bj * HALF + wc * 32 + 8 * fq; *(f32x4*)p = acc[ai][bj][m][0]; *(f32x4*)(p + 4) = acc[ai][bj][m][1]; } }
    }
};
struct EpiY {
    bf16_t* SG;
    __device__ __forceinline__ void operator()(const Acc& acc, const Unit& u, int wr, int wc, int fr, int fq) const {
        const int row0 = u.pm * BM + wr * 64 + fr;
#pragma unroll
        for (int ai = 0; ai < 2; ++ai)
#pragma unroll
            for (int m = 0; m < 4; ++m) { const int row = row0 + ai * HALF + m * 16; const int gq = row / NCH, ch = row - gq * NCH;
#pragma unroll
                for (int bj = 0; bj < 2; ++bj) {
                    const int c0 = u.pn * BM + bj * HALF + wc * 32 + 8 * fq, j = c0 >> 4, ho0 = c0 & 15;
                    float hv[8];
#pragma unroll
                    for (int e = 0; e < 8; ++e) { const float y = acc[ai][bj][m][e >> 2][e & 3]; const float z = 1.5957691216057308f * (y + 0.044715f * y * y * y);
                        hv[e] = y * fast_rcp(1.0f + fast_exp2(-z * LOG2E)); }
                    u32x4 w; w.x = cvt_pk_bf16(hv[0], hv[1]); w.y = cvt_pk_bf16(hv[2], hv[3]); w.z = cvt_pk_bf16(hv[4], hv[5]); w.w = cvt_pk_bf16(hv[6], hv[7]);
                    *(u32x4*)(SG + ((size_t)ch * 64 + j) * 512 + gq * 16 + ho0) = w;
                } }
    }
};
struct EpiGLU {
    const bf16_t* SG; bf16_t* MIX;
    __device__ __forceinline__ void operator()(const Acc& acc, const Unit& u, int wr, int wc, int fr, int fq) const {
        const int row0 = u.pm * BM + wr * 64 + fr;
#pragma unroll
        for (int ai = 0; ai < 2; ++ai)
#pragma unroll
            for (int m = 0; m < 4; ++m) { const int row = row0 + ai * HALF + m * 16;
#pragma unroll
                for (int bj = 0; bj < 2; ++bj) {
                    const int c0 = u.pn * BM + bj * HALF + wc * 32 + 8 * fq;
                    const u32x4 sw = *(const u32x4*)(SG + (size_t)row * 512 + c0);
                    const float sv[8] = {bf_lo(sw.x), bf_hi(sw.x), bf_lo(sw.y), bf_hi(sw.y), bf_lo(sw.z), bf_hi(sw.z), bf_lo(sw.w), bf_hi(sw.w)};
                    float hv[8];
#pragma unroll
                    for (int e = 0; e < 8; ++e) hv[e] = sv[e] * fast_rcp(1.0f + fast_exp2(-acc[ai][bj][m][e >> 2][e & 3] * LOG2E));
                    u32x4 w; w.x = cvt_pk_bf16(hv[0], hv[1]); w.y = cvt_pk_bf16(hv[2], hv[3]); w.z = cvt_pk_bf16(hv[4], hv[5]); w.w = cvt_pk_bf16(hv[6], hv[7]);
                    *(u32x4*)(MIX + (size_t)row * DM + 512 + c0) = w;
                }
                if (m & 1) MEMFENCE(); }
    }
};
}

namespace att {
constexpr int NW = 8, QBLK = 32, KVBLK = 64;
constexpr int SHM_V = KVBLK * 128 * 2, SHM_K = KVBLK * 64 * 2;
constexpr int OFF_V = 0, OFF_K = 2 * SHM_V, OFF_WS = OFF_K + 2 * SHM_K, OFF_ST = OFF_WS + NW * 64 * 4, LDS_BYTES = OFF_ST + 65536;
constexpr float THR = 8.f;
#define KSWZ(row, colB) ((row) * 128 + ((colB) ^ ((((row) >> 1) & 7) << 4)))
#define SBAR() __builtin_amdgcn_sched_barrier(0)
__device__ __forceinline__ int crow(int r, int hi) { return (r & 3) + 8 * (r >> 2) + 4 * hi; }
__device__ __forceinline__ void partialSM(f32x16& p0, f32x16& p1, float& m_reg, float& alpha) {
    float pmax = p0[0];
#pragma unroll
    for (int r = 1; r < 16; ++r) pmax = fmaxf(pmax, p0[r]);
#pragma unroll
    for (int r = 0; r < 16; ++r) pmax = fmaxf(pmax, p1[r]);
    { auto rr = __builtin_amdgcn_permlane32_swap(__float_as_uint(pmax), __float_as_uint(pmax), false, false); pmax = fmaxf(__uint_as_float(rr[0]), __uint_as_float(rr[1])); }
    float mn;
    if (__builtin_expect(__all(pmax - m_reg <= THR), 1)) { mn = m_reg; alpha = 1.f; }
    else { mn = fmaxf(m_reg, pmax); alpha = fast_exp2(m_reg - mn); m_reg = mn; }
#pragma unroll
    for (int r = 0; r < 16; ++r) p0[r] -= mn;
#pragma unroll
    for (int r = 0; r < 16; ++r) p1[r] -= mn;
#pragma unroll
    for (int r = 0; r < 16; ++r) p0[r] = fast_exp2(p0[r]);
}
__device__ __forceinline__ void finishSM(f32x16& p0, f32x16& p1, float alpha, float& l_reg, bf16x8& pa0, bf16x8& pa1, bf16x8& pa2, bf16x8& pa3) {
#pragma unroll
    for (int r = 0; r < 16; ++r) p1[r] = fast_exp2(p1[r]);
    float ps = 0;
#pragma unroll
    for (int r = 0; r < 16; ++r) ps += p0[r];
#pragma unroll
    for (int r = 0; r < 16; ++r) ps += p1[r];
    { auto rr = __builtin_amdgcn_permlane32_swap(__float_as_uint(ps), __float_as_uint(ps), false, false); ps = __uint_as_float(rr[0]) + __uint_as_float(rr[1]); }
    l_reg = l_reg * alpha + ps;
#define PK4(P, BASE, OUT) do { unsigned a0 = cvt_pk_bf16(P[BASE + 0], P[BASE + 1]), a1 = cvt_pk_bf16(P[BASE + 2], P[BASE + 3]);   \
    unsigned b0 = cvt_pk_bf16(P[BASE + 4], P[BASE + 5]), b1 = cvt_pk_bf16(P[BASE + 6], P[BASE + 7]);                              \
    auto r0 = __builtin_amdgcn_permlane32_swap(a0, b0, false, false); auto r1 = __builtin_amdgcn_permlane32_swap(a1, b1, false, false); \
    u32x4 w = {r0[0], r1[0], r0[1], r1[1]}; OUT = *reinterpret_cast<bf16x8*>(&w); } while (0)
    PK4(p0, 0, pa0); PK4(p0, 8, pa1); PK4(p1, 0, pa2); PK4(p1, 8, pa3);
#undef PK4
}
__device__ __forceinline__ void qkt(f32x16& p0, f32x16& p1, const char* Ks, const bf16x8* qr, int r32, int hi) {
    p0 = f32x16{}; p1 = f32x16{};
#pragma unroll
    for (int d0 = 0; d0 < 4; ++d0) { const int cb = (d0 * 16 + hi * 8) * 2;
        const bf16x8 b0 = *reinterpret_cast<const bf16x8*>(Ks + KSWZ(r32, cb));
        const bf16x8 b1 = *reinterpret_cast<const bf16x8*>(Ks + KSWZ(32 + r32, cb));
        p0 = __builtin_amdgcn_mfma_f32_32x32x16_bf16(b0, qr[d0], p0, 0, 0, 0);
        p1 = __builtin_amdgcn_mfma_f32_32x32x16_bf16(b1, qr[d0], p1, 0, 0, 0); }
}
__device__ __forceinline__ int v_st(int k, int c) { const int kk = (k & ~0xC) | ((k & 4) << 1) | ((k & 8) >> 1); return ((kk >> 3) * 4 + (c >> 5)) * 512 + ((kk & 7) * 32 + (c & 31)) * 2; }
__device__ __forceinline__ int v_rd_base(int lane) { return ((lane & 3) << 3) | (((lane >> 2) & 3) << 6) | (((lane >> 4) & 1) << 5) | (((lane >> 5) & 1) << 8); }
constexpr int v_rd_off(int d0, int ks, int half) { return d0 * 512 + ks * 4096 + half * 2048; }
template <int OFF> __device__ __forceinline__ s16x4 tr_read(int vb) { s16x4 r; asm volatile("ds_read_b64_tr_b16 %0, %1 offset:%2" : "=&v"(r) : "v"(vb), "i"(OFF) : "memory"); return r; }
template <int D0> __device__ __forceinline__ void pv_one(f32x16& od, int vb, bf16x8 pa0, bf16x8 pa1, bf16x8 pa2, bf16x8 pa3) {
    const s16x4 l0 = tr_read<v_rd_off(D0, 0, 0)>(vb), h0 = tr_read<v_rd_off(D0, 0, 1)>(vb), l1 = tr_read<v_rd_off(D0, 1, 0)>(vb), h1 = tr_read<v_rd_off(D0, 1, 1)>(vb);
    const s16x4 l2 = tr_read<v_rd_off(D0, 2, 0)>(vb), h2 = tr_read<v_rd_off(D0, 2, 1)>(vb), l3 = tr_read<v_rd_off(D0, 3, 0)>(vb), h3 = tr_read<v_rd_off(D0, 3, 1)>(vb);
    asm volatile("s_waitcnt lgkmcnt(0)" ::: "memory"); SBAR();
#define PK(L, H) (bf16x8){L[0], L[1], L[2], L[3], H[0], H[1], H[2], H[3]}
    od = __builtin_amdgcn_mfma_f32_32x32x16_bf16(pa0, PK(l0, h0), od, 0, 0, 0);
    od = __builtin_amdgcn_mfma_f32_32x32x16_bf16(pa1, PK(l1, h1), od, 0, 0, 0);
    od = __builtin_amdgcn_mfma_f32_32x32x16_bf16(pa2, PK(l2, h2), od, 0, 0, 0);
    od = __builtin_amdgcn_mfma_f32_32x32x16_bf16(pa3, PK(l3, h3), od, 0, 0, 0);
#undef PK
}
__device__ __forceinline__ void pv_d0(f32x16* o, int vb, bf16x8 pa0, bf16x8 pa1, bf16x8 pa2, bf16x8 pa3) {
    pv_one<0>(o[0], vb, pa0, pa1, pa2, pa3); pv_one<1>(o[1], vb, pa0, pa1, pa2, pa3); pv_one<2>(o[2], vb, pa0, pa1, pa2, pa3); pv_one<3>(o[3], vb, pa0, pa1, pa2, pa3);
}
__device__ __forceinline__ bf16x8 ld8(const bf16_t* p) { return *reinterpret_cast<const bf16x8*>(p); }

template <int map>
__device__ __forceinline__ void attn_map(const bf16_t* __restrict__ Q12, const bf16_t* __restrict__ K12, const bf16_t* __restrict__ V, bf16_t* __restrict__ MIX,
                                         const float* __restrict__ subg, float lam, long row0, int seq, int h, int q0, char* lds) {
    const int tid = tidx(), wid = tid >> 6, lane = tid & 63, r32 = lane & 31, hi = lane >> 5;
    char* V_lds = lds + OFF_V; char* K_lds = lds + OFF_K;
    float* ws = (float*)(lds + OFF_WS) + wid * 64; float* li_l = ws; float* al_l = ws + 32;
    unsigned* stash = (unsigned*)(lds + OFF_ST);
    const int sr = tid >> 4, sc = (tid & 15) * 8, vst0 = v_st(sr, sc), vst1 = v_st(32 + sr, sc);
    const int kr = tid >> 3, kc = (tid & 7) * 8, kst = KSWZ(kr, kc * 2);
    const int vb0 = (int)(uintptr_t)V_lds + v_rd_base(lane);
    const int NT = seq / KVBLK;
    const bf16_t* Vh = V + row0 * 512 + h * 128;
    {
        const bf16_t* Qw = Q12 + (row0 + q0 + wid * QBLK + r32) * 512 + map * 256 + h * 64 + hi * 8;
        const bf16_t* Kh = K12 + row0 * 512 + map * 256 + h * 64;
        bf16x8 qr[4];
#pragma unroll
        for (int d0 = 0; d0 < 4; ++d0) qr[d0] = ld8(Qw + d0 * 16);
        float m_reg = -1e30f, l_reg = 0.f; f32x16 o[4] = {};
        struct { bf16x8 vs0, vs1, ks; } sr_[1];
#define SLOAD(i, k0) do { sr_[i].vs0 = ld8(&Vh[(long)((k0) + sr) * 512 + sc]); sr_[i].vs1 = ld8(&Vh[(long)((k0) + 32 + sr) * 512 + sc]); sr_[i].ks = ld8(&Kh[(long)((k0) + kr) * 512 + kc]); } while (0)
#define SWRITE(b, i) do { *(bf16x8*)(V_lds + (b) * SHM_V + vst0) = sr_[i].vs0; *(bf16x8*)(V_lds + (b) * SHM_V + vst1) = sr_[i].vs1; *(bf16x8*)(K_lds + (b) * SHM_K + kst) = sr_[i].ks; } while (0)
#define SWAIT() asm volatile("s_waitcnt vmcnt(0)" ::: "memory")
#define RESC(a) do { if (__any((a) < 1.f)) { if (hi == 0) al_l[r32] = (a); asm volatile("s_waitcnt lgkmcnt(0)" ::: "memory"); \
    _Pragma("unroll") for (int d = 0; d < 4; ++d) _Pragma("unroll") for (int r = 0; r < 16; ++r) o[d][r] *= al_l[crow(r, hi)]; } } while (0)
        f32x16 pA0, pA1, pB0, pB1; float alA, alB; bf16x8 pa0, pa1, pa2, pa3;
        SLOAD(0, 0); asm volatile("s_waitcnt vmcnt(0)" ::: "memory"); SWRITE(0, 0); __syncthreads();
        qkt(pA0, pA1, K_lds, qr, r32, hi); partialSM(pA0, pA1, m_reg, alA);
        SLOAD(0, KVBLK);
        SWAIT(); SWRITE(1, 0); __syncthreads();
        for (int j = 1; j + 1 < NT; j += 2) {
            SBAR(); qkt(pB0, pB1, K_lds + SHM_K, qr, r32, hi);
            finishSM(pA0, pA1, alA, l_reg, pa0, pa1, pa2, pa3); SBAR();
            SLOAD(0, (j + 1) * KVBLK); SBAR();
            pv_d0(o, vb0, pa0, pa1, pa2, pa3); partialSM(pB0, pB1, m_reg, alB);
            __syncthreads(); SWAIT(); SWRITE(0, 0);
            RESC(alB); __syncthreads();
            SBAR(); qkt(pA0, pA1, K_lds, qr, r32, hi);
            finishSM(pB0, pB1, alB, l_reg, pa0, pa1, pa2, pa3); SBAR();
            SLOAD(0, (j + 2) * KVBLK); SBAR();
            pv_d0(o, vb0 + SHM_V, pa0, pa1, pa2, pa3); partialSM(pA0, pA1, m_reg, alA);
            __syncthreads(); SWAIT(); SWRITE(1, 0);
            RESC(alA); __syncthreads();
        }
        SBAR(); qkt(pB0, pB1, K_lds + SHM_K, qr, r32, hi);
        finishSM(pA0, pA1, alA, l_reg, pa0, pa1, pa2, pa3); SBAR();
        pv_d0(o, vb0, pa0, pa1, pa2, pa3); partialSM(pB0, pB1, m_reg, alB);
        __syncthreads(); RESC(alB);
        finishSM(pB0, pB1, alB, l_reg, pa0, pa1, pa2, pa3); SBAR();
        pv_d0(o, vb0 + SHM_V, pa0, pa1, pa2, pa3);
#undef SLOAD
#undef SWRITE
#undef SWAIT
#undef RESC
        if (hi == 0) li_l[r32] = l_reg; asm volatile("s_waitcnt lgkmcnt(0)" ::: "memory");
        float rli[16];
#pragma unroll
        for (int r = 0; r < 16; ++r) rli[r] = fast_rcp(li_l[crow(r, hi)]);
        if (map == 0) {
#pragma unroll
            for (int d0 = 0; d0 < 4; ++d0)
#pragma unroll
                for (int r = 0; r < 16; r += 2) stash[wid * 2048 + (d0 * 8 + (r >> 1)) * 64 + lane] = cvt_pk_bf16(o[d0][r] * rli[r], o[d0][r + 1] * rli[r + 1]);
        } else {
            float ssq[16];
#pragma unroll
            for (int r = 0; r < 16; ++r) ssq[r] = 0.f;
#pragma unroll
            for (int d0 = 0; d0 < 4; ++d0)
#pragma unroll
                for (int r = 0; r < 16; r += 2) { const unsigned w = stash[wid * 2048 + (d0 * 8 + (r >> 1)) * 64 + lane];
                    const float v0 = bf_lo(w) - lam * (o[d0][r] * rli[r]), v1 = bf_hi(w) - lam * (o[d0][r + 1] * rli[r + 1]);
                    o[d0][r] = v0; o[d0][r + 1] = v1; ssq[r] += v0 * v0; ssq[r + 1] += v1 * v1; }
#pragma unroll
            for (int r = 0; r < 16; ++r) { float s = ssq[r]; s += __shfl_xor(s, 1); s += __shfl_xor(s, 2); s += __shfl_xor(s, 4); s += __shfl_xor(s, 8); s += __shfl_xor(s, 16);
                ssq[r] = rsqrtf(s * (1.0f / 128.0f) + 1e-5f) * 0.8f; }
            asm volatile("s_waitcnt lgkmcnt(0)" ::: "memory");
            bf16_t* stg = (bf16_t*)(stash + wid * 2048);
#pragma unroll
            for (int d0 = 0; d0 < 4; ++d0) { const float gn = subg[d0 * 32 + r32];
#pragma unroll
                for (int r = 0; r < 16; ++r) { const unsigned w = cvt_pk_bf16(o[d0][r] * ssq[r] * gn, 0.f); stg[crow(r, hi) * 128 + d0 * 32 + r32] = (bf16_t)(w & 0xffffu); } }
            asm volatile("s_waitcnt lgkmcnt(0)" ::: "memory");
            bf16_t* Ow = MIX + (row0 + q0 + wid * QBLK) * 1024 + h * 128;
#pragma unroll
            for (int i = 0; i < 8; ++i) { const int row = i * 4 + (lane >> 4), ch = lane & 15; const u32x4 v = *(const u32x4*)(stg + row * 128 + ch * 8); *(u32x4*)(Ow + (long)row * 1024 + ch * 8) = v; }
        }
        __syncthreads();
    }
}
__device__ __forceinline__ void attn_unit(const bf16_t* __restrict__ Q12, const bf16_t* __restrict__ K12, const bf16_t* __restrict__ V, bf16_t* __restrict__ MIX,
                                          const float* __restrict__ subg, float lam, long row0, int seq, int h, int q0, char* lds) {
    attn_map<0>(Q12, K12, V, MIX, subg, lam, row0, seq, h, q0, lds);
    attn_map<1>(Q12, K12, V, MIX, subg, lam, row0, seq, h, q0, lds);
}
#undef SBAR
}

struct Args { const float* in[28]; float* out; unsigned char* ws; int ph_lo, ph_hi; };
enum { I_XP = 0, I_XS, I_N1, I_G1, I_U1, I_D1, I_MIXN, I_WIN, I_LQ1, I_LK1, I_LQ2, I_LK2, I_SUBN, I_ARE, I_AIM, I_LDT, I_BRE, I_BIM, I_CRE, I_CIM, I_SSMD, I_WGLU, I_WOUT, I_N2, I_G2, I_U2, I_D2, I_FN };
constexpr int NPHASE = 13;
constexpr int LDS_BYTES = 147456;
constexpr int NTHR = 512;

struct cplx { double re, im; };
__device__ __forceinline__ cplx cmul(cplx a, cplx b) { return {a.re * b.re - a.im * b.im, a.re * b.im + a.im * b.re}; }
__device__ __forceinline__ void sincos_rev(double r, double& s, double& c) {
    const double x = r * 6.283185307179586476925 * 0.125, x2 = x * x;
    double sp = 1.0 / 6227020800.0; sp = sp * (-x2) + 1.0 / 39916800.0; sp = sp * (-x2) + 1.0 / 362880.0; sp = sp * (-x2) + 1.0 / 5040.0; sp = sp * (-x2) + 1.0 / 120.0; sp = sp * (-x2) + 1.0 / 6.0; sp = sp * (-x2) + 1.0; sp *= x;
    double cp = 1.0 / 87178291200.0; cp = cp * (-x2) + 1.0 / 479001600.0; cp = cp * (-x2) + 1.0 / 3628800.0; cp = cp * (-x2) + 1.0 / 40320.0; cp = cp * (-x2) + 1.0 / 720.0; cp = cp * (-x2) + 1.0 / 24.0; cp = cp * (-x2) + 0.5; cp = 1.0 - cp * x2;
#pragma unroll
    for (int i = 0; i < 3; ++i) { const double s2 = 2.0 * sp * cp, c2 = 1.0 - 2.0 * sp * sp; sp = s2; cp = c2; }
    s = sp; c = cp;
}
__device__ __forceinline__ void sincos_big(double ang, double& s, double& c) { const double t = ang * 0.15915494309189533576888; sincos_rev(t - rint(t), s, c); }

__device__ __forceinline__ void phase_tables(const Args& a, unsigned char* ws, unsigned char* dob) {
    const int gt = blockIdx.x * NTHR + tidx(), GN = gridDim.x * NTHR;
    f32x2* LPOW = (f32x2*)(dob + DO_LPOW); f32x2* BBAR = (f32x2*)(ws + WS_BBAR); f32x2* ROPE = (f32x2*)(ws + WS_ROPE);
    const float *are = a.in[I_ARE], *aim = a.in[I_AIM], *ldt = a.in[I_LDT], *bre = a.in[I_BRE], *bim = a.in[I_BIM];
    for (int i = gt; i < 4096 * 65; i += GN) { const int s = i / 65, k = i - s * 65, gq = s >> 7, dir = (s >> 6) & 1, p = s & 63, idx = (dir * 32 + gq) * 64 + p;
        const double dt = exp((double)ldt[idx]); const double mag = exp((double)k * (double)are[idx] * dt); double sn, cs; sincos_big((double)k * (double)aim[idx] * dt, sn, cs);
        LPOW[i] = (f32x2){(float)(mag * cs), (float)(mag * sn)}; }
    for (int i = gt; i < 4096 * 16; i += GN) { const int s = i >> 4, hh = i & 15, gq = s >> 7, dir = (s >> 6) & 1, p = s & 63, idx = (dir * 32 + gq) * 64 + p;
        const double ar = are[idx], ai = aim[idx], dt = exp((double)ldt[idx]); const double mag = exp(ar * dt); double sn, cs; sincos_big(ai * dt, sn, cs);
        const cplx num = {mag * cs - 1.0, mag * sn}; const double den = ar * ar + ai * ai; const cplx coef = {(num.re * ar + num.im * ai) / den, (num.im * ar - num.re * ai) / den};
        const cplx b = {(double)bre[(size_t)idx * 16 + hh], (double)bim[(size_t)idx * 16 + hh]}; const cplx r = cmul(coef, b);
        BBAR[i] = (f32x2){(float)r.re, (float)r.im}; }
    for (int i = gt; i < 4096 * 32; i += GN) { const int pos = i >> 5, j = i & 31; const float inv = powf(10000.0f, -(float)j / 32.0f); const float ang = (float)pos * inv;
        double sn, cs; sincos_big((double)ang, sn, cs); ROPE[i] = (f32x2){(float)cs, (float)sn}; }
    if (gt == 0) { float s1 = 0.f, s2 = 0.f; for (int i = 0; i < 64; ++i) { s1 += a.in[I_LQ1][i] * a.in[I_LK1][i]; s2 += a.in[I_LQ2][i] * a.in[I_LK2][i]; }
        ((float*)(ws + WS_SCAL))[0] = expf(s1) - expf(s2) + 0.2f; }
}
__device__ __forceinline__ unsigned f2bf(float f) { unsigned u = __builtin_bit_cast(unsigned, f); return (u + 0x7fffu + ((u >> 16) & 1u)) >> 16; }
__device__ __forceinline__ unsigned pk2(float lo, float hi) { return f2bf(lo) | (f2bf(hi) << 16); }
__device__ __forceinline__ void tr_item(const float* W, int N, bf16_t* WT, int ldt, int k0, int n0, int drow0, const float* gain, LAS float* scr, int lane) {
#pragma unroll 8
    for (int i = 0; i < 32; ++i) { const int kk = 2 * i + (lane >> 5); float v = W[(size_t)(k0 + kk) * N + n0 + (lane & 31)]; if (gain) v *= gain[k0 + kk]; scr[kk * 33 + (lane & 31)] = v; }
    LDS_WAIT(); MEMFENCE();
    const int c = lane & 7;
#pragma unroll
    for (int j = 0; j < 4; ++j) { const int n = (lane >> 3) + 8 * j; const LAS float* s = scr + (8 * c) * 33 + n;
        u32x4 o; o.x = pk2(s[0 * 33], s[1 * 33]); o.y = pk2(s[2 * 33], s[3 * 33]); o.z = pk2(s[4 * 33], s[5 * 33]); o.w = pk2(s[6 * 33], s[7 * 33]);
        *(u32x4*)(WT + (size_t)(drow0 + n) * ldt + k0 + 8 * c) = o; }
    LDS_WAIT(); MEMFENCE();
}
__device__ __forceinline__ float wave_sum(float v) {
#pragma unroll
    for (int o = 1; o < 64; o <<= 1) v += __shfl_xor(v, o);
    return v;
}
__device__ __forceinline__ void phase_prep(const Args& a, unsigned char* ws, unsigned char* dob, LAS unsigned char* lds) {
    const int tid = tidx(), lane = tid & 63, wave = tid >> 6;
    const int gw = blockIdx.x * 8 + wave, NGW = gridDim.x * 8;
    const int gt = blockIdx.x * NTHR + tid, GN = gridDim.x * NTHR;
    LAS float* scr = (LAS float*)(lds + wave * 16384);
    constexpr int I_FF = 16 * 88, I_FD = 44 * 32, I_IN = 16 * 64, I_OUT = 16 * 32, I_GLU = 8 * 16;
    static_assert(I_FF == I_FD, "item counts");
    constexpr int NITEMS = 6 * I_FF + I_IN + I_OUT + I_GLU;
    for (int it = gw; it < NITEMS; it += NGW) {
        int r = it;
        if (r < 6 * I_FF) {
            const int blk = r / I_FF, layer = blk / 3, kind = blk % 3; r -= blk * I_FF;
            const float* gain = a.in[layer ? I_N2 : I_N1];
            if (kind < 2) { const int kb = r / 88, nb = r % 88, n0 = nb * 32; const int drow0 = 256 * (n0 >> 7) + 128 * kind + (n0 & 127);
                tr_item(a.in[(layer ? I_G2 : I_G1) + kind], DFF, (bf16_t*)(ws + (layer ? WS_W2 : WS_W1)), 1024, kb * 64, n0, drow0, gain, scr, lane); }
            else { const int kb = r / 32, nb = r % 32; tr_item(a.in[layer ? I_D2 : I_D1], 1024, (bf16_t*)(ws + (layer ? WS_W2D : WS_W1D)), DFF, kb * 64, nb * 32, nb * 32, nullptr, scr, lane); }
            continue;
        }
        r -= 6 * I_FF;
        if (r < I_IN) { const int kb = r / 64, nb = r % 64, n0 = nb * 32; int drow0 = n0;
            if (n0 < 1024) { const int L = n0 & 255; drow0 = (n0 & ~255) + ((L >> 5) & 1) * 128 + (L >> 6) * 32; }
            tr_item(a.in[I_WIN], 2048, (bf16_t*)(ws + WS_WIN), 1024, kb * 64, n0, drow0, a.in[I_MIXN], scr, lane); continue; }
        r -= I_IN;
        if (r < I_OUT) { const int kb = r / 32, nb = r % 32; tr_item(a.in[I_WOUT], 1024, (bf16_t*)(ws + WS_WOUT), 1024, kb * 64, nb * 32, nb * 32, nullptr, scr, lane); continue; }
        r -= I_OUT;
        { const int kb = r / 16, nb = r % 16; tr_item(a.in[I_WGLU], 512, (bf16_t*)(ws + WS_WGLU), 512, kb * 64, nb * 32, nb * 32, nullptr, scr, lane); }
    }
    const f32x2* LPOW = (const f32x2*)(dob + DO_LPOW); const f32x2* BBAR = (const f32x2*)(ws + WS_BBAR);
    const float *cre = a.in[I_CRE], *cim = a.in[I_CIM];
    float* KK = (float*)(dob + DO_KK);
    for (int i = gt; i < 32 * 2 * 64 * 16; i += GN) { const int ho = i & 15, k = (i >> 4) & 63, dir = (i >> 10) & 1, gq = i >> 11;
        const int s0 = (gq * 2 + dir) * 64; const size_t cb = ((size_t)(dir * 32 + gq) * 16 + ho) * 64;
        float accv[16];
#pragma unroll
        for (int e = 0; e < 16; ++e) accv[e] = 0.f;
        for (int p = 0; p < 64; ++p) { const f32x2 L = LPOW[(size_t)(s0 + p) * 65 + k]; const float cr = cre[cb + p], ci = cim[cb + p];
            const float tr = cr * L.x - ci * L.y, ti = cr * L.y + ci * L.x; const f32x2* bb = BBAR + (size_t)(s0 + p) * 16;
#pragma unroll
            for (int e = 0; e < 16; ++e) { const f32x2 b = bb[e]; accv[e] += tr * b.x - ti * b.y; } }
        if (dir == 0 && k == 0) accv[ho] += a.in[I_SSMD][gq * 16 + ho];
        float* dst = KK + (((size_t)(gq * 2 + dir) * 64 + k) * 16 + ho) * 16;
#pragma unroll
        for (int e = 0; e < 16; e += 4) *(f32x4*)(dst + e) = (f32x4){accv[e], accv[e + 1], accv[e + 2], accv[e + 3]}; }
    bf16_t* WSM = (bf16_t*)(dob + DO_WSM);
    for (int i = gt; i < 32 * 256 * 64 * 2; i += GN) { const int half = i & 1, ii = (i >> 1) & 63, n = (i >> 7) & 255, gq = i >> 15; const int dir = n >> 7, ri = (n >> 6) & 1, p = n & 63;
        const int s = (gq * 2 + dir) * 64 + p; const f32x2 L = LPOW[(size_t)s * 65 + (dir ? ii : 63 - ii)]; const f32x2* bb = BBAR + (size_t)s * 16 + half * 8;
        float v[8];
#pragma unroll
        for (int e = 0; e < 8; ++e) { const f32x2 b = bb[e]; v[e] = ri ? (L.x * b.y + L.y * b.x) : (L.x * b.x - L.y * b.y); }
        u32x4 w; w.x = pk2(v[0], v[1]); w.y = pk2(v[2], v[3]); w.z = pk2(v[4], v[5]); w.w = pk2(v[6], v[7]);
        *(u32x4*)(WSM + ((size_t)(gq * 256 + n)) * 1024 + ii * 16 + half * 8) = w; }
    bf16_t* BTY = (bf16_t*)(dob + DO_BTY);
    for (int i = gt; i < 32 * 1024 * 32; i += GN) { const int pb = i & 7, ri = (i >> 3) & 1, dir = (i >> 4) & 1, n = (i >> 5) & 1023, gq = i >> 15; const int j = n >> 4, ho = n & 15;
        const int s0 = (gq * 2 + dir) * 64 + pb * 8; const size_t cb = ((size_t)(dir * 32 + gq) * 16 + ho) * 64 + pb * 8; const int e = dir ? 64 - j : j + 1;
        float v[8];
#pragma unroll
        for (int q = 0; q < 8; ++q) { const f32x2 L = LPOW[(size_t)(s0 + q) * 65 + e]; const float cr = cre[cb + q], ci = cim[cb + q]; v[q] = ri ? -(cr * L.y + ci * L.x) : (cr * L.x - ci * L.y); }
        u32x4 w; w.x = pk2(v[0], v[1]); w.y = pk2(v[2], v[3]); w.z = pk2(v[4], v[5]); w.w = pk2(v[6], v[7]);
        *(u32x4*)(BTY + ((size_t)(gq * 1024 + n)) * LDU + 1024 + dir * 128 + ri * 64 + pb * 8) = w; }
    bf16_t* XB = (bf16_t*)(ws + WS_XB); float* SS = (float*)(ws + WS_SS);
    for (int m = gw; m < MT; m += NGW) {
        const float* xrow = m < MP ? a.in[I_XP] + (size_t)m * DM : a.in[I_XS] + (size_t)(m - MP) * DM;
        const f32x4* xr = (const f32x4*)xrow + lane; f32x4 v[4]; float s = 0.f;
#pragma unroll
        for (int j = 0; j < 4; ++j) { v[j] = xr[64 * j]; s += (v[j].x * v[j].x + v[j].y * v[j].y) + (v[j].z * v[j].z + v[j].w * v[j].w); }
        s = wave_sum(s);
        u32x2* o8 = (u32x2*)(XB + (size_t)m * DM) + lane;
#pragma unroll
        for (int j = 0; j < 4; ++j) o8[64 * j] = (u32x2){pk2(v[j].x, v[j].y), pk2(v[j].z, v[j].w)};
        if (lane < 16) SS[(size_t)m * 16 + lane] = lane == 0 ? s : 0.f;
    }
}
__device__ __forceinline__ void phase_toeplitz(unsigned char* dob) {
    const int gt = blockIdx.x * NTHR + tidx(), GN = gridDim.x * NTHR;
    const float* KK = (const float*)(dob + DO_KK); bf16_t* BTY = (bf16_t*)(dob + DO_BTY);
    for (int it = gt; it < 32 * 1024 * 128; it += GN) { const int half = it & 1, i = (it >> 1) & 63, n = (it >> 7) & 1023, gq = it >> 17; const int j = n >> 4, ho = n & 15;
        f32x4 v0 = {0.f, 0.f, 0.f, 0.f}, v1 = v0;
        if (j >= i) { const float* s = KK + (((size_t)(gq * 2 + 0) * 64 + (j - i)) * 16 + ho) * 16 + half * 8; v0 += *(const f32x4*)s; v1 += *(const f32x4*)(s + 4); }
        if (i >= j) { const float* s = KK + (((size_t)(gq * 2 + 1) * 64 + (i - j)) * 16 + ho) * 16 + half * 8; v0 += *(const f32x4*)s; v1 += *(const f32x4*)(s + 4); }
        u32x4 w; w.x = pk2(v0.x, v0.y); w.y = pk2(v0.z, v0.w); w.z = pk2(v1.x, v1.y); w.w = pk2(v1.z, v1.w);
        *(u32x4*)(BTY + ((size_t)(gq * 1024 + n)) * LDU + i * 16 + half * 8) = w; }
}
__device__ __forceinline__ void phase_chunkscan(unsigned char* ws, unsigned char* dob) {
    const int gt = blockIdx.x * NTHR + tidx(), GN = gridDim.x * NTHR;
    const f32x2* LPOW = (const f32x2*)(dob + DO_LPOW); const float* S = (const float*)(ws + WS_S); bf16_t* UH = (bf16_t*)(ws + WS_UH);
    for (int it = gt; it < 32 * 40 * 128; it += GN) { const int p = it & 63, dir = (it >> 6) & 1, rest = it >> 7, bt = rest % 40, gq = rest / 40;
        const int c0 = bt < 32 ? bt * 32 : 1024 + (bt - 32) * 64, nc = bt < 32 ? 32 : 64;
        const f32x2 L = LPOW[(size_t)((gq * 2 + dir) * 64 + p) * 65 + 64];
        float hr = 0.f, hi_ = 0.f;
        for (int cc = 0; cc < nc; ++cc) { const int c = dir ? nc - 1 - cc : cc; const size_t row = (size_t)gq * NCH + c0 + c;
            bf16_t* d = UH + row * LDU + 1024 + dir * 128 + p; d[0] = (bf16_t)f2bf(hr); d[64] = (bf16_t)f2bf(hi_);
            const float sr = S[row * 256 + dir * 128 + p], si = S[row * 256 + dir * 128 + 64 + p];
            const float nr = L.x * hr - L.y * hi_ + sr, ni = L.x * hi_ + L.y * hr + si; hr = nr; hi_ = ni; } }
}
__device__ __forceinline__ void phase_attn(const Args& a, unsigned char* ws, unsigned char* dob, char* lds) {
    const float lam = ((const float*)(ws + WS_SCAL))[0];
    const bf16_t* Q12 = (const bf16_t*)(ws + WS_Q12); const bf16_t* K12 = (const bf16_t*)(ws + WS_K12); const bf16_t* V = (const bf16_t*)(ws + WS_V); bf16_t* MIX = (bf16_t*)(dob + DO_MIX);
    for (int u = blockIdx.x; u < 1536; u += gridDim.x) {
        long row0; int seq, h, q0;
        if (u < 512) { const int i = u >> 8, cc = u & 255, x = cc & 7, j = cc >> 3; const int bh = (i * 8 + x) * 2 + (j >> 4), qb = j & 15; row0 = MP + (long)(bh >> 2) * LSM; seq = LSM; h = bh & 3; q0 = qb * 256; }
        else { const int v = u - 512, i = v >> 8, cc = v & 255, x = cc & 7, j = cc >> 3; const int bh = (i * 8 + x) * 4 + (j >> 3), qb = j & 7; row0 = (long)(bh >> 2) * LPR; seq = LPR; h = bh & 3; q0 = qb * 256; }
        att::attn_unit(Q12, K12, V, MIX, a.in[I_SUBN], lam, row0, seq, h, q0, lds);
    }
}
__device__ __forceinline__ void phase_final(const Args& a) {
    const int tid = tidx(), lane = tid & 63, gw = blockIdx.x * 8 + (tid >> 6), NGW = gridDim.x * 8;
    const f32x4* gp = (const f32x4*)a.in[I_FN] + lane; f32x4 gv[4];
#pragma unroll
    for (int j = 0; j < 4; ++j) gv[j] = gp[64 * j];
    for (int m = gw; m < MT; m += NGW) { f32x4* xr = (f32x4*)(a.out + (size_t)m * DM) + lane; f32x4 v[4]; float s = 0.f;
#pragma unroll
        for (int j = 0; j < 4; ++j) { v[j] = xr[64 * j]; s += (v[j].x * v[j].x + v[j].y * v[j].y) + (v[j].z * v[j].z + v[j].w * v[j].w); }
        const float ri = rsqrtf(wave_sum(s) * (1.0f / 1024.0f) + 1e-6f);
#pragma unroll
        for (int j = 0; j < 4; ++j) xr[64 * j] = v[j] * ri * gv[j]; }
}

__global__ void __launch_bounds__(NTHR, 2) fwd_kernel(Args a) {
    extern __shared__ __attribute__((aligned(16))) unsigned char lds[];
    LAS unsigned char* L3 = (LAS unsigned char*)lds;
    unsigned char* ws = a.ws; unsigned char* dob = (unsigned char*)a.out;
    const int G = gridDim.x, lo = a.ph_lo, hi = a.ph_hi;
#ifndef ONLY_PHASE
#define ONLY_PHASE -1
#endif
#define IN(k) ((ONLY_PHASE < 0 || ONLY_PHASE == (k)) && lo <= (k) && (k) < hi)
#if MK_MULTI
#define SEAM(k) do { } while (0)
#else
#define SEAM(k) do { if (IN(k) && IN((k) + 1)) { cg::this_grid().sync(); } } while (0)
#endif
    bf16_t* XB = (bf16_t*)(ws + WS_XB); bf16_t* H = (bf16_t*)(ws + WS_H); float* SS = (float*)(ws + WS_SS);
    pg8::StaticOrder S;
    if (IN(0)) { phase_tables(a, ws, dob); } SEAM(0);
    if (IN(1)) { phase_prep(a, ws, dob, L3); __syncthreads(); } SEAM(1);
    if (IN(2)) {
        phase_toeplitz(dob);
        pg8::Gemm g{XB, (const bf16_t*)(ws + WS_W1), MT, 2 * DFF, 1024, 1024, 1024, 0, 0}; S.init(MT, 2 * DFF, G, (int)blockIdx.x);
        pg8::EpiSwiGLU E{H, SS}; pg8::gemm_phase(L3, g, S, E);
    } SEAM(2);
    if (IN(3)) {
        pg8::Gemm g{H, (const bf16_t*)(ws + WS_W1D), MT, 1024, DFF, DFF, DFF, 0, 0}; S.init(MT, 1024, G, (int)blockIdx.x);
        pg8::EpiRes E{a.in[I_XP], a.in[I_XS], nullptr, 0.5f, nullptr, XB, SS}; pg8::gemm_phase(L3, g, S, E);
    } SEAM(3);
    if (IN(4)) {
        pg8::Gemm g{XB, (const bf16_t*)(ws + WS_WIN), MT, 2048, 1024, 1024, 1024, 0, 0}; S.init(MT, 2048, G, (int)blockIdx.x);
        pg8::EpiProj E{SS, (const f32x4*)(ws + WS_ROPE), (bf16_t*)(ws + WS_Q12), (bf16_t*)(ws + WS_K12), (bf16_t*)(ws + WS_V), (bf16_t*)(ws + WS_UH)}; pg8::gemm_phase(L3, g, S, E);
    } SEAM(4);
    if (IN(5)) {
        pg8::Gemm g{(const bf16_t*)(ws + WS_UH), (const bf16_t*)(dob + DO_WSM), MG, 256, 1024, LDU, 1024, 6, 1}; S.init(MG, 256, G, (int)blockIdx.x);
        pg8::EpiS E{(float*)(ws + WS_S)}; pg8::gemm_phase(L3, g, S, E);
    } SEAM(5);
    if (IN(6)) { phase_chunkscan(ws, dob); phase_attn(a, ws, dob, (char*)lds); } SEAM(6);
    if (IN(7)) {
        pg8::Gemm g{(const bf16_t*)(ws + WS_UH), (const bf16_t*)(dob + DO_BTY), MG, 1024, LDU, LDU, LDU, 6, 4}; S.init(MG, 1024, G, (int)blockIdx.x);
        pg8::EpiY E{(bf16_t*)(ws + WS_Q12)}; pg8::gemm_phase(L3, g, S, E);
    } SEAM(7);
    if (IN(8)) {
        pg8::Gemm g{(const bf16_t*)(ws + WS_Q12), (const bf16_t*)(ws + WS_WGLU), MT, 512, 512, 512, 512, 0, 0}; S.init(MT, 512, G, (int)blockIdx.x);
        pg8::EpiGLU E{(const bf16_t*)(ws + WS_Q12), (bf16_t*)(dob + DO_MIX)}; pg8::gemm_phase(L3, g, S, E);
    } SEAM(8);
    if (IN(9)) {
        pg8::Gemm g{(const bf16_t*)(dob + DO_MIX), (const bf16_t*)(ws + WS_WOUT), MT, 1024, 1024, 1024, 1024, 0, 0}; S.init(MT, 1024, G, (int)blockIdx.x);
        pg8::EpiRes E{nullptr, nullptr, XB, 1.0f, nullptr, XB, SS}; pg8::gemm_phase(L3, g, S, E);
    } SEAM(9);
    if (IN(10)) {
        pg8::Gemm g{XB, (const bf16_t*)(ws + WS_W2), MT, 2 * DFF, 1024, 1024, 1024, 0, 0}; S.init(MT, 2 * DFF, G, (int)blockIdx.x);
        pg8::EpiSwiGLU E{H, SS}; pg8::gemm_phase(L3, g, S, E);
    } SEAM(10);
    if (IN(11)) {
        pg8::Gemm g{H, (const bf16_t*)(ws + WS_W2D), MT, 1024, DFF, DFF, DFF, 0, 0}; S.init(MT, 1024, G, (int)blockIdx.x);
        pg8::EpiRes E{nullptr, nullptr, XB, 0.5f, a.out, nullptr, nullptr}; pg8::gemm_phase(L3, g, S, E);
    } SEAM(11);
    if (IN(12)) { phase_final(a); }
#undef IN
#undef SEAM
}

extern "C" void kernel_launch(void* const* d_in, const int* in_sizes, int n_in, void* d_out, int out_size, void* d_ws, size_t ws_size, hipStream_t stream) {
    static int grid = 0;
    if (grid == 0) {
        if (n_in != 28 || in_sizes[0] != MP * DM || out_size != MT * DM || ws_size < WS_END) { fprintf(stderr, "kernel_launch: unexpected shapes n_in %d in0 %d out %d ws %zu\n", n_in, n_in > 0 ? in_sizes[0] : -1, out_size, ws_size); grid = -1; return; }
        int dev = 0, cus = 0, per_cu = 0;
        hipGetDevice(&dev); hipDeviceGetAttribute(&cus, hipDeviceAttributeMultiprocessorCount, dev);
        if (hipFuncSetAttribute((const void*)fwd_kernel, hipFuncAttributeMaxDynamicSharedMemorySize, LDS_BYTES) != hipSuccess) { fprintf(stderr, "kernel_launch: hipFuncSetAttribute failed\n"); grid = -1; return; }
        if (hipOccupancyMaxActiveBlocksPerMultiprocessor(&per_cu, (const void*)fwd_kernel, NTHR, LDS_BYTES) != hipSuccess || per_cu < 1) { fprintf(stderr, "kernel_launch: occupancy query says %d\n", per_cu); per_cu = 1; }
        (void)hipGetLastError();
        grid = cus * 1;
    }
    if (grid < 0) return;
    Args a{};
    for (int i = 0; i < 28; ++i) a.in[i] = (const float*)d_in[i];
    a.out = (float*)d_out; a.ws = (unsigned char*)d_ws;
#if MK_MULTI
    for (int p = 0; p < NPHASE; ++p) { a.ph_lo = p; a.ph_hi = p + 1; hipLaunchKernelGGL(fwd_kernel, dim3(grid), dim3(NTHR), LDS_BYTES, stream, a); }
#else
    a.ph_lo = 0; a.ph_hi = NPHASE;
    void* args[] = {&a};
    hipError_t e = hipLaunchCooperativeKernel((const void*)fwd_kernel, dim3(grid), dim3(NTHR), args, LDS_BYTES, stream);
    if (e != hipSuccess) fprintf(stderr, "kernel_launch: cooperative launch failed: %s (grid %d)\n", hipGetErrorString(e), grid);
#endif
}
```

```cpp
#include <hip/hip_runtime.h>
#include <hip/hip_cooperative_groups.h>
#include <cstdio>
#include <cstdint>
namespace cg = cooperative_groups;

#ifndef MK_MULTI
#define MK_MULTI 0
#endif

#ifndef PROBE_PHASE
#define PROBE_PHASE -1
#endif
#define LAS __attribute__((address_space(3)))
#define GAS __attribute__((address_space(1)))
typedef unsigned short bf16_t;
typedef short bf16x8 __attribute__((ext_vector_type(8)));
typedef short s16x4 __attribute__((ext_vector_type(4)));
typedef float f32x4 __attribute__((ext_vector_type(4)));
typedef float f32x2 __attribute__((ext_vector_type(2)));
typedef float f32x16 __attribute__((ext_vector_type(16)));
typedef unsigned u32x4 __attribute__((ext_vector_type(4)));
typedef unsigned u32x2 __attribute__((ext_vector_type(2)));

constexpr int DM = 1024, MP = 65536, MT = 98304, LPR = 2048, LSM = 4096, DFF = 2816;
constexpr int NCH = MT / 64;
constexpr int MG = 32 * NCH;
constexpr int LDU = 1280;
constexpr float C2 = 0.125f * 1.4426950408889634f;
constexpr float LOG2E = 1.4426950408889634f;

constexpr size_t MiB = (size_t)1 << 20;
constexpr size_t WS_XB = 0;
constexpr size_t WS_H = 192 * MiB;
constexpr size_t WS_Q12 = 192 * MiB;
constexpr size_t WS_K12 = 288 * MiB;
constexpr size_t WS_V = 384 * MiB;
constexpr size_t WS_UH = 480 * MiB;
constexpr size_t WS_S = 600 * MiB;
constexpr size_t WS_W1 = 720 * MiB, WS_W1D = 731 * MiB, WS_WIN = 737 * MiB, WS_WOUT = 741 * MiB, WS_WGLU = 743 * MiB, WS_W2 = 744 * MiB, WS_W2D = 755 * MiB;
constexpr size_t WS_SS = 761 * MiB;
constexpr size_t WS_ROPE = 767 * MiB;
constexpr size_t WS_BBAR = 768 * MiB;
constexpr size_t WS_SCAL = 769 * MiB;
constexpr size_t WS_END = 770 * MiB;
constexpr size_t DO_MIX = 0;
constexpr size_t DO_BTY = 192 * MiB;
constexpr size_t DO_WSM = 272 * MiB;
constexpr size_t DO_LPOW = 288 * MiB;
constexpr size_t DO_KK = 292 * MiB;

#define LDS_WAIT() asm volatile("s_waitcnt lgkmcnt(0)" ::: "memory")
#define VM_WAIT() asm volatile("s_waitcnt vmcnt(0)" ::: "memory")
#define MEMFENCE() asm volatile("" ::: "memory")

__device__ __forceinline__ int tidx() { int t = threadIdx.x; asm volatile("" : "+v"(t)); return t; }
__device__ __forceinline__ unsigned cvt_pk_bf16(float lo, float hi) { unsigned r; asm volatile("v_cvt_pk_bf16_f32 %0, %1, %2" : "=v"(r) : "v"(lo), "v"(hi)); return r; }
__device__ __forceinline__ float bf_lo(unsigned w) { return __uint_as_float(w << 16); }
__device__ __forceinline__ float bf_hi(unsigned w) { return __uint_as_float(w & 0xffff0000u); }
__device__ __forceinline__ float fast_rcp(float x) { return __builtin_amdgcn_rcpf(x); }
__device__ __forceinline__ float fast_exp2(float x) { return __builtin_amdgcn_exp2f(x); }
__device__ __forceinline__ float rinv_of(const float* ss, int row) { return rsqrtf(ss[row] * (1.0f / 1024.0f) + 1e-6f); }

namespace pg8 {
constexpr int BM = 256, BK = 64, HALF = 128, HTB = HALF * BK * 2, STAGE_BYTES = 8 * HTB, NXCD = 8, WGM = 8;
__host__ __device__ __forceinline__ int lds_byte(int r, int c) { const int st = (r >> 4) * 2 + (c >> 5), rr = r & 15, cc = c & 31, ob = rr * 64 + cc * 2; return st * 1024 + (ob ^ (((ob >> 9) & 1) << 5)); }
__host__ __device__ __forceinline__ void stage_rc(int b, int& R, int& C) { const int st = b / 1024, sb = b % 1024, swz = sb ^ (((sb >> 9) & 1) << 5); R = (st >> 1) * 16 + swz / 64; C = (st & 1) * 32 + (swz % 64) / 2; }
__host__ __device__ __forceinline__ int perm32(int rho) { const int n = rho >> 4, i = rho & 15; return 8 * (i >> 2) + 4 * n + (i & 3); }
struct Unit { int pm, pn; };
struct Gemm { const bf16_t* A; const bf16_t* Bt; int M, N, K, lda, ldb, gdiv, gtiles; };
struct StaticOrder {
    int nM, nN, nwg, G, c;
    __device__ void init(int M, int N, int G_, int c_) { nM = M / BM; nN = N / BM; nwg = nM * nN; G = G_; c = c_; }
    __device__ bool next(int i, Unit& u) const {
        const long L = (long)i * G + c; if (L >= nwg) return false;
        int wgid = (int)L; { const int q = nwg / NXCD, r = nwg % NXCD, xcd = wgid % NXCD, off = wgid / NXCD; wgid = (xcd < r ? xcd * (q + 1) : r * (q + 1) + (xcd - r) * q) + off; }
        const int nig = WGM * nN, gid = wgid / nig, fm = gid * WGM, gsz = (nM - fm) < WGM ? (nM - fm) : WGM;
        u.pm = fm + ((wgid % nig) % gsz); u.pn = (wgid % nig) / gsz; return true;
    }
};
template <class Epi>
__device__ __forceinline__ void gemm_phase(LAS unsigned char* lds, const Gemm g, const StaticOrder& S, const Epi& E) {
    const int tid = tidx(), wid = __builtin_amdgcn_readfirstlane(tid >> 6), lane = tid & 63, wr = wid >> 2, wc = wid & 3, fr = lane & 15, fq = lane >> 4;
    const int K = g.K, nt = K / BK;
    unsigned voffA[2], voffB[2];
#pragma unroll
    for (int i = 0; i < 2; ++i) { int R, C; stage_rc(tid * 16 + i * 8192, R, C); const int Rb = (R & ~31) + perm32(R & 31);
        voffA[i] = (unsigned)(R * g.lda + C) * 2u; voffB[i] = (unsigned)(Rb * g.ldb + C) * 2u; }
    const size_t kstep = (size_t)(BK * 2);
    const size_t hstepA = (size_t)HALF * g.lda * 2, hstepB = (size_t)HALF * g.ldb * 2;
    const size_t tstepA = 2 * hstepA, tstepB = 2 * hstepB;
    const unsigned ldsw = (unsigned)wid * 1024u;
    const int aoff = lds_byte(wr * 64 + fr, fq * 8), boff = lds_byte(wc * 32 + fr, fq * 8);
#define PG8_BT(u) ((u).pn + (g.gdiv ? ((u).pm / g.gdiv) * g.gtiles : 0))
#define PG8_SA(b, h) (((b) * 2 + (h)) * HTB)
#define PG8_SB(b, h) ((4 + (b) * 2 + (h)) * HTB)
#define PG8_STAGE(bufoff, gbase, voff) do { _Pragma("unroll") for (int _i = 0; _i < 2; ++_i) \
        __builtin_amdgcn_global_load_lds((const unsigned*)((const char*)(gbase) + (voff)[_i]), (LAS unsigned*)(lds + (bufoff) + ldsw + _i * 8192), 16, 0, 0); } while (0)
#define PG8_LDA(dst, b, h) do { _Pragma("unroll") for (int m = 0; m < 4; ++m) _Pragma("unroll") for (int k = 0; k < 2; ++k) dst[m][k] = *(const LAS bf16x8*)(lds + PG8_SA(b, h) + aoff + m * 2048 + k * 1024); } while (0)
#define PG8_LDB(dst, b, h) do { _Pragma("unroll") for (int n = 0; n < 2; ++n) _Pragma("unroll") for (int k = 0; k < 2; ++k) dst[n][k] = *(const LAS bf16x8*)(lds + PG8_SB(b, h) + boff + n * 2048 + k * 1024); } while (0)
#define PG8_MMA(ai, bj, At, Bt) do { __builtin_amdgcn_s_setprio(1); _Pragma("unroll") for (int m = 0; m < 4; ++m) _Pragma("unroll") for (int n = 0; n < 2; ++n) _Pragma("unroll") for (int k = 0; k < 2; ++k) \
        acc[ai][bj][m][n] = __builtin_amdgcn_mfma_f32_16x16x32_bf16(Bt[n][k], At[m][k], acc[ai][bj][m][n], 0, 0, 0); __builtin_amdgcn_s_setprio(0); } while (0)
#define PG8_WAIT_V(n) asm volatile("s_waitcnt vmcnt(" #n ")" ::: "memory")
#define PG8_WAIT_L(n) asm volatile("s_waitcnt lgkmcnt(" #n ")" ::: "memory")
#define PG8_BAR __builtin_amdgcn_s_barrier()
#define PG8_SCHED __builtin_amdgcn_sched_barrier(0)
    Unit cur, nxt; int ui = 0;
    if (!S.next(0, cur)) return;
    f32x4 acc[2][2][4][2];
#pragma unroll
    for (int a = 0; a < 2; ++a)
#pragma unroll
        for (int b = 0; b < 2; ++b)
#pragma unroll
            for (int m = 0; m < 4; ++m)
#pragma unroll
                for (int n = 0; n < 2; ++n) acc[a][b][m][n] = (f32x4){0.f, 0.f, 0.f, 0.f};
    bf16x8 At[4][2], B0[2][2], B1[2][2];
    const char* cA = (const char*)g.A + (size_t)cur.pm * tstepA; const char* cB = (const char*)g.Bt + (size_t)PG8_BT(cur) * tstepB;
    PG8_STAGE(PG8_SB(0, 0), cB, voffB); PG8_STAGE(PG8_SB(0, 1), cB + hstepB, voffB); PG8_STAGE(PG8_SA(0, 0), cA, voffA); PG8_STAGE(PG8_SA(0, 1), cA + hstepA, voffA);
    if (wr == 1) PG8_BAR;
    PG8_WAIT_V(2); PG8_BAR;
    PG8_STAGE(PG8_SB(1, 0), cB + kstep, voffB); PG8_STAGE(PG8_SA(1, 0), cA + kstep, voffA); PG8_STAGE(PG8_SB(1, 1), cB + hstepB + kstep, voffB);
    PG8_WAIT_V(6); PG8_BAR;
    for (;;) {
        const bool has_next = S.next(ui + 1, nxt);
        const char* nA = has_next ? (const char*)g.A + (size_t)nxt.pm * tstepA : cA; const char* nB = has_next ? (const char*)g.Bt + (size_t)PG8_BT(nxt) * tstepB : cB;
        for (int t = 0; t < nt; t += 2) {
            const bool last = (t == nt - 2);
            const char* a1 = cA + (size_t)(t + 1) * kstep;
            const char* a2 = last ? nA : cA + (size_t)(t + 2) * kstep; const char* b2 = last ? nB : cB + (size_t)(t + 2) * kstep;
            const char* a3 = a2 + kstep; const char* b3 = b2 + kstep;
            PG8_LDB(B0, 0, 0); PG8_LDB(B1, 0, 1); PG8_SCHED; PG8_LDA(At, 0, 0); PG8_STAGE(PG8_SA(1, 1), a1 + hstepA, voffA);
            PG8_WAIT_V(8); PG8_WAIT_L(0); PG8_BAR; PG8_MMA(0, 0, At, B0); PG8_MMA(0, 1, At, B1); PG8_BAR; PG8_SCHED;
            PG8_LDA(At, 0, 1); PG8_STAGE(PG8_SB(0, 0), b2, voffB); PG8_STAGE(PG8_SB(0, 1), b2 + hstepB, voffB); PG8_STAGE(PG8_SA(0, 0), a2, voffA);
            PG8_WAIT_V(8); PG8_WAIT_L(0); PG8_BAR; PG8_MMA(1, 0, At, B0); PG8_MMA(1, 1, At, B1); PG8_BAR; PG8_SCHED;
            PG8_LDB(B0, 1, 0); PG8_LDB(B1, 1, 1); PG8_SCHED; PG8_LDA(At, 1, 0); PG8_STAGE(PG8_SA(0, 1), a2 + hstepA, voffA);
            PG8_WAIT_V(8); PG8_WAIT_L(0); PG8_BAR; PG8_MMA(0, 0, At, B0); PG8_MMA(0, 1, At, B1); PG8_BAR; PG8_SCHED;
            PG8_LDA(At, 1, 1); PG8_STAGE(PG8_SB(1, 0), b3, voffB); PG8_STAGE(PG8_SB(1, 1), b3 + hstepB, voffB); PG8_STAGE(PG8_SA(1, 0), a3, voffA);
            PG8_WAIT_V(8); PG8_WAIT_L(0); PG8_BAR; PG8_MMA(1, 0, At, B0); PG8_MMA(1, 1, At, B1); PG8_BAR; PG8_SCHED;
        }
        if (wr == 0) PG8_BAR;
        E(acc, cur, wr, wc, fr, fq);
        if (!has_next) break;
#pragma unroll
        for (int a = 0; a < 2; ++a)
#pragma unroll
            for (int b = 0; b < 2; ++b)
#pragma unroll
                for (int m = 0; m < 4; ++m)
#pragma unroll
                    for (int n = 0; n < 2; ++n) acc[a][b][m][n] = (f32x4){0.f, 0.f, 0.f, 0.f};
        cur = nxt; cA = nA; cB = nB; ++ui;
        if (wr == 1) PG8_BAR;
    }
    PG8_WAIT_V(0);
    PG8_BAR;
#undef PG8_BT
#undef PG8_SA
#undef PG8_SB
#undef PG8_STAGE
#undef PG8_LDA
#undef PG8_LDB
#undef PG8_MMA
#undef PG8_WAIT_V
#undef PG8_WAIT_L
#undef PG8_BAR
#undef PG8_SCHED
}

typedef f32x4 Acc[2][2][4][2];

struct EpiSwiGLU {
    bf16_t* H; const float* ss;
    __device__ __forceinline__ void operator()(const Acc& acc, const Unit& u, int wr, int wc, int fr, int fq) const {
        const int row0 = u.pm * BM + wr * 64 + fr, col0 = u.pn * 128 + wc * 32 + 8 * fq;
        float rv[2][4];
#pragma unroll
        for (int ai = 0; ai < 2; ++ai)
#pragma unroll
            for (int m = 0; m < 4; ++m) rv[ai][m] = ss[row0 + ai * HALF + m * 16];
#pragma unroll
        for (int ai = 0; ai < 2; ++ai)
#pragma unroll
            for (int m = 0; m < 4; ++m) {
                const int row = row0 + ai * HALF + m * 16; const float ri = rsqrtf(rv[ai][m] * (1.0f / 1024.0f) + 1e-6f);
                float hv[8];
#pragma unroll
                for (int n = 0; n < 2; ++n)
#pragma unroll
                    for (int j = 0; j < 4; ++j) { const float gt = acc[ai][0][m][n][j] * ri, up = acc[ai][1][m][n][j] * ri;
                        hv[n * 4 + j] = gt * up * fast_rcp(1.0f + fast_exp2(-gt * LOG2E)); }
                u32x4 w; w.x = cvt_pk_bf16(hv[0], hv[1]); w.y = cvt_pk_bf16(hv[2], hv[3]); w.z = cvt_pk_bf16(hv[4], hv[5]); w.w = cvt_pk_bf16(hv[6], hv[7]);
                *(u32x4*)(H + (size_t)row * DFF + col0) = w;
            }
    }
};
template <bool B16> struct EpiRes {
    const float* baseP; const float* baseS; const bf16_t* base16; float alpha; float* out32; bf16_t* out16; float* ss;
    __device__ __forceinline__ void operator()(const Acc& acc, const Unit& u, int wr, int wc, int fr, int fq) const {
        const int row0 = u.pm * BM + wr * 64 + fr;
        const GAS float* b32 = (u.pm < MP / BM) ? (const GAS float*)baseP : (const GAS float*)baseS - (size_t)MP * DM;
#pragma unroll
        for (int ai = 0; ai < 2; ++ai) {
            u32x4 p16[4][2]; f32x4 p32[4][2][2];
#pragma unroll
            for (int m = 0; m < 4; ++m)
#pragma unroll
                for (int bj = 0; bj < 2; ++bj) { const size_t off = (size_t)(row0 + ai * HALF + m * 16) * DM + u.pn * BM + bj * HALF + wc * 32 + 8 * fq;
                    if (B16) p16[m][bj] = *(const u32x4*)(base16 + off); else { p32[m][bj][0] = *(const GAS f32x4*)(b32 + off); p32[m][bj][1] = *(const GAS f32x4*)(b32 + off + 4); } }
#pragma unroll
            for (int m = 0; m < 4; ++m) {
                const int row = row0 + ai * HALF + m * 16; float sq = 0.f;
#pragma unroll
                for (int bj = 0; bj < 2; ++bj) {
                    const size_t off = (size_t)row * DM + u.pn * BM + bj * HALF + wc * 32 + 8 * fq;
                    f32x4 b0, b1;
                    if (B16) { const u32x4 w = p16[m][bj]; b0 = (f32x4){bf_lo(w.x), bf_hi(w.x), bf_lo(w.y), bf_hi(w.y)}; b1 = (f32x4){bf_lo(w.z), bf_hi(w.z), bf_lo(w.w), bf_hi(w.w)}; }
                    else { b0 = p32[m][bj][0]; b1 = p32[m][bj][1]; }
                    const f32x4 v0 = b0 + acc[ai][bj][m][0] * alpha, v1 = b1 + acc[ai][bj][m][1] * alpha;
                    sq += (v0.x * v0.x + v0.y * v0.y) + (v0.z * v0.z + v0.w * v0.w) + (v1.x * v1.x + v1.y * v1.y) + (v1.z * v1.z + v1.w * v1.w);
                    if (out32) { *(f32x4*)(out32 + off) = v0; *(f32x4*)(out32 + off + 4) = v1; }
                    if (out16) { u32x4 w; w.x = cvt_pk_bf16(v0.x, v0.y); w.y = cvt_pk_bf16(v0.z, v0.w); w.z = cvt_pk_bf16(v1.x, v1.y); w.w = cvt_pk_bf16(v1.z, v1.w); *(u32x4*)(out16 + off) = w; }
                }
                if (ss) { sq += __shfl_xor(sq, 16); sq += __shfl_xor(sq, 32); if (fq == 0) __hip_atomic_fetch_add(ss + row, sq, __ATOMIC_RELAXED, __HIP_MEMORY_SCOPE_AGENT); }
            }
            MEMFENCE();
        }
    }
};
struct EpiProj {
    const float* ss; const f32x4* rope; bf16_t *Q12, *K12, *V, *UH;
    __device__ __forceinline__ void operator()(const Acc& acc, const Unit& u, int wr, int wc, int fr, int fq) const {
        const int row0 = u.pm * BM + wr * 64 + fr; const int pn = u.pn;
        float rv[2][4];
#pragma unroll
        for (int ai = 0; ai < 2; ++ai)
#pragma unroll
            for (int m = 0; m < 4; ++m) rv[ai][m] = ss[row0 + ai * HALF + m * 16];
#pragma unroll
        for (int am = 0; am < 4; ++am) {
            const int ai = am >> 1;
            f32x4 rp[2][4];
            if (pn < 4) {
#pragma unroll
                for (int mm = 0; mm < 2; ++mm) { const int m = (am & 1) * 2 + mm; const int row = row0 + ai * HALF + m * 16; const int pos = row < MP ? (row & (LPR - 1)) : ((row - MP) & (LSM - 1));
                    const f32x4* p = rope + (size_t)pos * 16 + 4 * fq;
#pragma unroll
                    for (int q = 0; q < 4; ++q) rp[mm][q] = p[q]; }
            }
#pragma unroll
            for (int mm = 0; mm < 2; ++mm) {
                const int m = (am & 1) * 2 + mm;
                const int row = row0 + ai * HALF + m * 16; const float ri = rsqrtf(rv[ai][m] * (1.0f / 1024.0f) + 1e-6f);
                if (pn < 4) {
                    const float sc = (pn < 2 ? C2 : 1.0f) * ri;
                    float o1[8], o2[8];
#pragma unroll
                    for (int q = 0; q < 4; ++q) { const f32x4 cs = rp[mm][q];
                        { const int e = 2 * q; const float x1 = acc[ai][0][m][e >> 2][e & 3] * sc, x2 = acc[ai][1][m][e >> 2][e & 3] * sc; o1[e] = x1 * cs.x - x2 * cs.y; o2[e] = x2 * cs.x + x1 * cs.y; }
                        { const int e = 2 * q + 1; const float x1 = acc[ai][0][m][e >> 2][e & 3] * sc, x2 = acc[ai][1][m][e >> 2][e & 3] * sc; o1[e] = x1 * cs.z - x2 * cs.w; o2[e] = x2 * cs.z + x1 * cs.w; } }
                    bf16_t* dst = (pn < 2 ? Q12 : K12) + (size_t)row * 512 + (pn & 1) * 256 + wc * 64 + 8 * fq;
                    u32x4 w; w.x = cvt_pk_bf16(o1[0], o1[1]); w.y = cvt_pk_bf16(o1[2], o1[3]); w.z = cvt_pk_bf16(o1[4], o1[5]); w.w = cvt_pk_bf16(o1[6], o1[7]); *(u32x4*)dst = w;
                    w.x = cvt_pk_bf16(o2[0], o2[1]); w.y = cvt_pk_bf16(o2[2], o2[3]); w.z = cvt_pk_bf16(o2[4], o2[5]); w.w = cvt_pk_bf16(o2[6], o2[7]); *(u32x4*)(dst + 32) = w;
                } else {
#pragma unroll
                    for (int bj = 0; bj < 2; ++bj) {
                        const f32x4 v0 = acc[ai][bj][m][0] * ri, v1 = acc[ai][bj][m][1] * ri;
                        u32x4 w; w.x = cvt_pk_bf16(v0.x, v0.y); w.y = cvt_pk_bf16(v0.z, v0.w); w.z = cvt_pk_bf16(v1.x, v1.y); w.w = cvt_pk_bf16(v1.z, v1.w);
                        const int c0 = (pn & 1) * 256 + bj * HALF + wc * 32 + 8 * fq;
                        if (pn < 6) *(u32x4*)(V + (size_t)row * 512 + c0) = w;
                        else { const int gq = c0 >> 4, hi0 = c0 & 15; *(u32x4*)(UH + ((size_t)gq * NCH + (row >> 6)) * LDU + (row & 63) * 16 + hi0) = w; }
                    }
                }
            }
            MEMFENCE();
        }
    }
};
struct EpiS {
    float* S;
    __device__ __forceinline__ void operator()(const Acc& acc, const Unit& u, int wr, int wc, int fr, int fq) const {
        const int row0 = u.pm * BM + wr * 64 + fr;
#pragma unroll
        for (int ai = 0; ai < 2; ++ai)
#pragma unroll
            for (int m = 0; m < 4; ++m) { const int row = row0 + ai * HALF + m * 16;
#pragma unroll
                for (int bj = 0; bj < 2; ++bj) { float* p = S + (size_t)row * 256 + bj * HALF + wc * 32 + 8 * fq; *(f32x4*)p = acc[ai][bj][m][0]; *(f32x4*)(p + 4) = acc[ai][bj][m][1]; } }
    }
};
struct EpiY {
    bf16_t* SG;
    __device__ __forceinline__ void operator()(const Acc& acc, const Unit& u, int wr, int wc, int fr, int fq) const {
        const int row0 = u.pm * BM + wr * 64 + fr;
#pragma unroll
        for (int ai = 0; ai < 2; ++ai)
#pragma unroll
            for (int m = 0; m < 4; ++m) { const int row = row0 + ai * HALF + m * 16; const int gq = row / NCH, ch = row - gq * NCH;
#pragma unroll
                for (int bj = 0; bj < 2; ++bj) {
                    const int c0 = u.pn * BM + bj * HALF + wc * 32 + 8 * fq, j = c0 >> 4, ho0 = c0 & 15;
                    float hv[8];
#pragma unroll
                    for (int e = 0; e < 8; ++e) { const float y = acc[ai][bj][m][e >> 2][e & 3]; const float z = 1.5957691216057308f * (y + 0.044715f * y * y * y);
                        hv[e] = y * fast_rcp(1.0f + fast_exp2(-z * LOG2E)); }
                    u32x4 w; w.x = cvt_pk_bf16(hv[0], hv[1]); w.y = cvt_pk_bf16(hv[2], hv[3]); w.z = cvt_pk_bf16(hv[4], hv[5]); w.w = cvt_pk_bf16(hv[6], hv[7]);
                    *(u32x4*)(SG + ((size_t)ch * 64 + j) * 512 + gq * 16 + ho0) = w;
                } }
    }
};
struct EpiGLU {
    const bf16_t* SG; bf16_t* MIX;
    __device__ __forceinline__ void operator()(const Acc& acc, const Unit& u, int wr, int wc, int fr, int fq) const {
        const int row0 = u.pm * BM + wr * 64 + fr;
#pragma unroll
        for (int ai = 0; ai < 2; ++ai) {
            u32x4 pre[4][2];
#pragma unroll
            for (int m = 0; m < 4; ++m)
#pragma unroll
                for (int bj = 0; bj < 2; ++bj) pre[m][bj] = *(const u32x4*)(SG + (size_t)(row0 + ai * HALF + m * 16) * 512 + u.pn * BM + bj * HALF + wc * 32 + 8 * fq);
#pragma unroll
            for (int m = 0; m < 4; ++m) { const int row = row0 + ai * HALF + m * 16;
#pragma unroll
                for (int bj = 0; bj < 2; ++bj) {
                    const int c0 = u.pn * BM + bj * HALF + wc * 32 + 8 * fq;
                    const u32x4 sw = pre[m][bj];
                    const float sv[8] = {bf_lo(sw.x), bf_hi(sw.x), bf_lo(sw.y), bf_hi(sw.y), bf_lo(sw.z), bf_hi(sw.z), bf_lo(sw.w), bf_hi(sw.w)};
                    float hv[8];
#pragma unroll
                    for (int e = 0; e < 8; ++e) hv[e] = sv[e] * fast_rcp(1.0f + fast_exp2(-acc[ai][bj][m][e >> 2][e & 3] * LOG2E));
                    u32x4 w; w.x = cvt_pk_bf16(hv[0], hv[1]); w.y = cvt_pk_bf16(hv[2], hv[3]); w.z = cvt_pk_bf16(hv[4], hv[5]); w.w = cvt_pk_bf16(hv[6], hv[7]);
                    *(u32x4*)(MIX + (size_t)row * DM + 512 + c0) = w;
                } }
            MEMFENCE();
        }
    }
};
}

namespace att {
constexpr int NW = 8, QBLK = 32, KVBLK = 64;
constexpr int SHM_V = KVBLK * 128 * 2, SHM_K = KVBLK * 64 * 2;
constexpr int OFF_V = 0, OFF_K = 2 * SHM_V, OFF_WS = OFF_K + 2 * SHM_K, OFF_ST = OFF_WS + NW * 64 * 4, LDS_BYTES = OFF_ST + 65536;
constexpr float THR = 8.f;
#define KSWZ(row, colB) ((row) * 128 + ((colB) ^ ((((row) >> 1) & 7) << 4)))
#define SBAR() __builtin_amdgcn_sched_barrier(0)
__device__ __forceinline__ int crow(int r, int hi) { return (r & 3) + 8 * (r >> 2) + 4 * hi; }
__device__ __forceinline__ void partialSM(f32x16& p0, f32x16& p1, float& m_reg, float& alpha) {
    float pmax = p0[0];
#pragma unroll
    for (int r = 1; r < 16; ++r) pmax = fmaxf(pmax, p0[r]);
#pragma unroll
    for (int r = 0; r < 16; ++r) pmax = fmaxf(pmax, p1[r]);
    { auto rr = __builtin_amdgcn_permlane32_swap(__float_as_uint(pmax), __float_as_uint(pmax), false, false); pmax = fmaxf(__uint_as_float(rr[0]), __uint_as_float(rr[1])); }
    float mn;
    if (__builtin_expect(__all(pmax - m_reg <= THR), 1)) { mn = m_reg; alpha = 1.f; }
    else { mn = fmaxf(m_reg, pmax); alpha = fast_exp2(m_reg - mn); m_reg = mn; }
#pragma unroll
    for (int r = 0; r < 16; ++r) p0[r] -= mn;
#pragma unroll
    for (int r = 0; r < 16; ++r) p1[r] -= mn;
#pragma unroll
    for (int r = 0; r < 16; ++r) p0[r] = fast_exp2(p0[r]);
}
__device__ __forceinline__ void finishSM(f32x16& p0, f32x16& p1, float alpha, float& l_reg, bf16x8& pa0, bf16x8& pa1, bf16x8& pa2, bf16x8& pa3) {
#pragma unroll
    for (int r = 0; r < 16; ++r) p1[r] = fast_exp2(p1[r]);
    float ps = 0;
#pragma unroll
    for (int r = 0; r < 16; ++r) ps += p0[r];
#pragma unroll
    for (int r = 0; r < 16; ++r) ps += p1[r];
    { auto rr = __builtin_amdgcn_permlane32_swap(__float_as_uint(ps), __float_as_uint(ps), false, false); ps = __uint_as_float(rr[0]) + __uint_as_float(rr[1]); }
    l_reg = l_reg * alpha + ps;
#define PK4(P, BASE, OUT) do { unsigned a0 = cvt_pk_bf16(P[BASE + 0], P[BASE + 1]), a1 = cvt_pk_bf16(P[BASE + 2], P[BASE + 3]);   \
    unsigned b0 = cvt_pk_bf16(P[BASE + 4], P[BASE + 5]), b1 = cvt_pk_bf16(P[BASE + 6], P[BASE + 7]);                              \
    auto r0 = __builtin_amdgcn_permlane32_swap(a0, b0, false, false); auto r1 = __builtin_amdgcn_permlane32_swap(a1, b1, false, false); \
    u32x4 w = {r0[0], r1[0], r0[1], r1[1]}; OUT = *reinterpret_cast<bf16x8*>(&w); } while (0)
    PK4(p0, 0, pa0); PK4(p0, 8, pa1); PK4(p1, 0, pa2); PK4(p1, 8, pa3);
#undef PK4
}
__device__ __forceinline__ void qkt(f32x16& p0, f32x16& p1, const char* Ks, const bf16x8* qr, int r32, int hi) {
    p0 = f32x16{}; p1 = f32x16{};
#pragma unroll
    for (int d0 = 0; d0 < 4; ++d0) { const int cb = (d0 * 16 + hi * 8) * 2;
        const bf16x8 b0 = *reinterpret_cast<const bf16x8*>(Ks + KSWZ(r32, cb));
        const bf16x8 b1 = *reinterpret_cast<const bf16x8*>(Ks + KSWZ(32 + r32, cb));
        p0 = __builtin_amdgcn_mfma_f32_32x32x16_bf16(b0, qr[d0], p0, 0, 0, 0);
        p1 = __builtin_amdgcn_mfma_f32_32x32x16_bf16(b1, qr[d0], p1, 0, 0, 0); }
}
__device__ __forceinline__ int v_st(int k, int c) { const int kk = (k & ~0xC) | ((k & 4) << 1) | ((k & 8) >> 1); return ((kk >> 3) * 4 + (c >> 5)) * 512 + ((kk & 7) * 32 + (c & 31)) * 2; }
__device__ __forceinline__ int v_rd_base(int lane) { return ((lane & 3) << 3) | (((lane >> 2) & 3) << 6) | (((lane >> 4) & 1) << 5) | (((lane >> 5) & 1) << 8); }
constexpr int v_rd_off(int d0, int ks, int half) { return d0 * 512 + ks * 4096 + half * 2048; }
template <int OFF> __device__ __forceinline__ s16x4 tr_read(int vb) { s16x4 r; asm volatile("ds_read_b64_tr_b16 %0, %1 offset:%2" : "=&v"(r) : "v"(vb), "i"(OFF) : "memory"); return r; }
template <int D0> __device__ __forceinline__ void pv_one(f32x16& od, int vb, bf16x8 pa0, bf16x8 pa1, bf16x8 pa2, bf16x8 pa3) {
    const s16x4 l0 = tr_read<v_rd_off(D0, 0, 0)>(vb), h0 = tr_read<v_rd_off(D0, 0, 1)>(vb), l1 = tr_read<v_rd_off(D0, 1, 0)>(vb), h1 = tr_read<v_rd_off(D0, 1, 1)>(vb);
    const s16x4 l2 = tr_read<v_rd_off(D0, 2, 0)>(vb), h2 = tr_read<v_rd_off(D0, 2, 1)>(vb), l3 = tr_read<v_rd_off(D0, 3, 0)>(vb), h3 = tr_read<v_rd_off(D0, 3, 1)>(vb);
    asm volatile("s_waitcnt lgkmcnt(0)" ::: "memory"); SBAR();
#define PK(L, H) (bf16x8){L[0], L[1], L[2], L[3], H[0], H[1], H[2], H[3]}
    od = __builtin_amdgcn_mfma_f32_32x32x16_bf16(pa0, PK(l0, h0), od, 0, 0, 0);
    od = __builtin_amdgcn_mfma_f32_32x32x16_bf16(pa1, PK(l1, h1), od, 0, 0, 0);
    od = __builtin_amdgcn_mfma_f32_32x32x16_bf16(pa2, PK(l2, h2), od, 0, 0, 0);
    od = __builtin_amdgcn_mfma_f32_32x32x16_bf16(pa3, PK(l3, h3), od, 0, 0, 0);
#undef PK
}
__device__ __forceinline__ void pv_d0(f32x16* o, int vb, bf16x8 pa0, bf16x8 pa1, bf16x8 pa2, bf16x8 pa3) {
    pv_one<0>(o[0], vb, pa0, pa1, pa2, pa3); pv_one<1>(o[1], vb, pa0, pa1, pa2, pa3); pv_one<2>(o[2], vb, pa0, pa1, pa2, pa3); pv_one<3>(o[3], vb, pa0, pa1, pa2, pa3);
}
__device__ __forceinline__ bf16x8 ld8(const bf16_t* p) { return *reinterpret_cast<const bf16x8*>(p); }

template <int map>
__device__ __forceinline__ void attn_map(const bf16_t* __restrict__ Q12, const bf16_t* __restrict__ K12, const bf16_t* __restrict__ V, bf16_t* __restrict__ MIX,
                                         const float* __restrict__ subg, float lam, long row0, int seq, int h, int q0, char* lds) {
    const int tid = tidx(), wid = tid >> 6, lane = tid & 63, r32 = lane & 31, hi = lane >> 5;
    char* V_lds = lds + OFF_V; char* K_lds = lds + OFF_K;
    float* ws = (float*)(lds + OFF_WS) + wid * 64; float* li_l = ws; float* al_l = ws + 32;
    unsigned* stash = (unsigned*)(lds + OFF_ST);
    const int sr = tid >> 4, sc = (tid & 15) * 8, vst0 = v_st(sr, sc), vst1 = v_st(32 + sr, sc);
    const int kr = tid >> 3, kc = (tid & 7) * 8, kst = KSWZ(kr, kc * 2);
    const int vb0 = (int)(uintptr_t)V_lds + v_rd_base(lane);
    const int NT = seq / KVBLK;
    const bf16_t* Vh = V + row0 * 512 + h * 128;
    {
        const bf16_t* Qw = Q12 + (row0 + q0 + wid * QBLK + r32) * 512 + map * 256 + h * 64 + hi * 8;
        const bf16_t* Kh = K12 + row0 * 512 + map * 256 + h * 64;
        bf16x8 qr[4];
#pragma unroll
        for (int d0 = 0; d0 < 4; ++d0) qr[d0] = ld8(Qw + d0 * 16);
        float m_reg = -1e30f, l_reg = 0.f; f32x16 o[4] = {};
        struct { bf16x8 vs0, vs1, ks; } sr_[1];
#define SLOAD(i, k0) do { sr_[i].vs0 = ld8(&Vh[(long)((k0) + sr) * 512 + sc]); sr_[i].vs1 = ld8(&Vh[(long)((k0) + 32 + sr) * 512 + sc]); sr_[i].ks = ld8(&Kh[(long)((k0) + kr) * 512 + kc]); } while (0)
#define SWRITE(b, i) do { *(bf16x8*)(V_lds + (b) * SHM_V + vst0) = sr_[i].vs0; *(bf16x8*)(V_lds + (b) * SHM_V + vst1) = sr_[i].vs1; *(bf16x8*)(K_lds + (b) * SHM_K + kst) = sr_[i].ks; } while (0)
#define SWAIT() asm volatile("s_waitcnt vmcnt(0)" ::: "memory")
#define RESC(a) do { if (__any((a) < 1.f)) { if (hi == 0) al_l[r32] = (a); asm volatile("s_waitcnt lgkmcnt(0)" ::: "memory"); \
    _Pragma("unroll") for (int d = 0; d < 4; ++d) _Pragma("unroll") for (int r = 0; r < 16; ++r) o[d][r] *= al_l[crow(r, hi)]; } } while (0)
        f32x16 pA0, pA1, pB0, pB1; float alA, alB; bf16x8 pa0, pa1, pa2, pa3;
        SLOAD(0, 0); asm volatile("s_waitcnt vmcnt(0)" ::: "memory"); SWRITE(0, 0); __syncthreads();
        qkt(pA0, pA1, K_lds, qr, r32, hi); partialSM(pA0, pA1, m_reg, alA);
        SLOAD(0, KVBLK);
        SWAIT(); SWRITE(1, 0); __syncthreads();
        for (int j = 1; j + 1 < NT; j += 2) {
            SBAR(); qkt(pB0, pB1, K_lds + SHM_K, qr, r32, hi);
            finishSM(pA0, pA1, alA, l_reg, pa0, pa1, pa2, pa3); SBAR();
            SLOAD(0, (j + 1) * KVBLK); SBAR();
            pv_d0(o, vb0, pa0, pa1, pa2, pa3); partialSM(pB0, pB1, m_reg, alB);
            __syncthreads(); SWAIT(); SWRITE(0, 0);
            RESC(alB); __syncthreads();
            SBAR(); qkt(pA0, pA1, K_lds, qr, r32, hi);
            finishSM(pB0, pB1, alB, l_reg, pa0, pa1, pa2, pa3); SBAR();
            SLOAD(0, (j + 2) * KVBLK); SBAR();
            pv_d0(o, vb0 + SHM_V, pa0, pa1, pa2, pa3); partialSM(pA0, pA1, m_reg, alA);
            __syncthreads(); SWAIT(); SWRITE(1, 0);
            RESC(alA); __syncthreads();
        }
        SBAR(); qkt(pB0, pB1, K_lds + SHM_K, qr, r32, hi);
        finishSM(pA0, pA1, alA, l_reg, pa0, pa1, pa2, pa3); SBAR();
        pv_d0(o, vb0, pa0, pa1, pa2, pa3); partialSM(pB0, pB1, m_reg, alB);
        __syncthreads(); RESC(alB);
        finishSM(pB0, pB1, alB, l_reg, pa0, pa1, pa2, pa3); SBAR();
        pv_d0(o, vb0 + SHM_V, pa0, pa1, pa2, pa3);
#undef SLOAD
#undef SWRITE
#undef SWAIT
#undef RESC
        if (hi == 0) li_l[r32] = l_reg; asm volatile("s_waitcnt lgkmcnt(0)" ::: "memory");
        float rli[16];
#pragma unroll
        for (int r = 0; r < 16; ++r) rli[r] = fast_rcp(li_l[crow(r, hi)]);
        if (map == 0) {
#pragma unroll
            for (int d0 = 0; d0 < 4; ++d0)
#pragma unroll
                for (int r = 0; r < 16; r += 2) stash[wid * 2048 + (d0 * 8 + (r >> 1)) * 64 + lane] = cvt_pk_bf16(o[d0][r] * rli[r], o[d0][r + 1] * rli[r + 1]);
        } else {
            float ssq[16];
#pragma unroll
            for (int r = 0; r < 16; ++r) ssq[r] = 0.f;
#pragma unroll
            for (int d0 = 0; d0 < 4; ++d0)
#pragma unroll
                for (int r = 0; r < 16; r += 2) { const unsigned w = stash[wid * 2048 + (d0 * 8 + (r >> 1)) * 64 + lane];
                    const float v0 = bf_lo(w) - lam * (o[d0][r] * rli[r]), v1 = bf_hi(w) - lam * (o[d0][r + 1] * rli[r + 1]);
                    o[d0][r] = v0; o[d0][r + 1] = v1; ssq[r] += v0 * v0; ssq[r + 1] += v1 * v1; }
#pragma unroll
            for (int r = 0; r < 16; ++r) { float s = ssq[r]; s += __shfl_xor(s, 1); s += __shfl_xor(s, 2); s += __shfl_xor(s, 4); s += __shfl_xor(s, 8); s += __shfl_xor(s, 16);
                ssq[r] = rsqrtf(s * (1.0f / 128.0f) + 1e-5f) * 0.8f; }
            asm volatile("s_waitcnt lgkmcnt(0)" ::: "memory");
            bf16_t* stg = (bf16_t*)(stash + wid * 2048);
#pragma unroll
            for (int d0 = 0; d0 < 4; ++d0) { const float gn = subg[d0 * 32 + r32];
#pragma unroll
                for (int r = 0; r < 16; ++r) { const unsigned w = cvt_pk_bf16(o[d0][r] * ssq[r] * gn, 0.f); stg[crow(r, hi) * 128 + d0 * 32 + r32] = (bf16_t)(w & 0xffffu); } }
            asm volatile("s_waitcnt lgkmcnt(0)" ::: "memory");
            bf16_t* Ow = MIX + (row0 + q0 + wid * QBLK) * 1024 + h * 128;
#pragma unroll
            for (int i = 0; i < 8; ++i) { const int row = i * 4 + (lane >> 4), ch = lane & 15; const u32x4 v = *(const u32x4*)(stg + row * 128 + ch * 8); *(u32x4*)(Ow + (long)row * 1024 + ch * 8) = v; }
        }
        __syncthreads();
    }
}
__device__ __forceinline__ void attn_unit(const bf16_t* __restrict__ Q12, const bf16_t* __restrict__ K12, const bf16_t* __restrict__ V, bf16_t* __restrict__ MIX,
                                          const float* __restrict__ subg, float lam, long row0, int seq, int h, int q0, char* lds) {
    attn_map<0>(Q12, K12, V, MIX, subg, lam, row0, seq, h, q0, lds);
    attn_map<1>(Q12, K12, V, MIX, subg, lam, row0, seq, h, q0, lds);
}
#undef SBAR
}

struct Args { const float* in[28]; float* out; unsigned char* ws; int ph_lo, ph_hi; };
enum { I_XP = 0, I_XS, I_N1, I_G1, I_U1, I_D1, I_MIXN, I_WIN, I_LQ1, I_LK1, I_LQ2, I_LK2, I_SUBN, I_ARE, I_AIM, I_LDT, I_BRE, I_BIM, I_CRE, I_CIM, I_SSMD, I_WGLU, I_WOUT, I_N2, I_G2, I_U2, I_D2, I_FN };
constexpr int NPHASE = 13;
constexpr int LDS_BYTES = 147456;
constexpr int NTHR = 512;

struct cplx { double re, im; };
__device__ __forceinline__ cplx cmul(cplx a, cplx b) { return {a.re * b.re - a.im * b.im, a.re * b.im + a.im * b.re}; }
__device__ __forceinline__ void sincos_rev(double r, double& s, double& c) {
    const double x = r * 6.283185307179586476925 * 0.125, x2 = x * x;
    double sp = 1.0 / 6227020800.0; sp = sp * (-x2) + 1.0 / 39916800.0; sp = sp * (-x2) + 1.0 / 362880.0; sp = sp * (-x2) + 1.0 / 5040.0; sp = sp * (-x2) + 1.0 / 120.0; sp = sp * (-x2) + 1.0 / 6.0; sp = sp * (-x2) + 1.0; sp *= x;
    double cp = 1.0 / 87178291200.0; cp = cp * (-x2) + 1.0 / 479001600.0; cp = cp * (-x2) + 1.0 / 3628800.0; cp = cp * (-x2) + 1.0 / 40320.0; cp = cp * (-x2) + 1.0 / 720.0; cp = cp * (-x2) + 1.0 / 24.0; cp = cp * (-x2) + 0.5; cp = 1.0 - cp * x2;
#pragma unroll
    for (int i = 0; i < 3; ++i) { const double s2 = 2.0 * sp * cp, c2 = 1.0 - 2.0 * sp * sp; sp = s2; cp = c2; }
    s = sp; c = cp;
}
__device__ __forceinline__ void sincos_big(double ang, double& s, double& c) { const double t = ang * 0.15915494309189533576888; sincos_rev(t - rint(t), s, c); }

__device__ __forceinline__ void phase_tables(const Args& a, unsigned char* ws, unsigned char* dob) {
    const int gt = blockIdx.x * NTHR + tidx(), GN = gridDim.x * NTHR;
    f32x2* LPOW = (f32x2*)(dob + DO_LPOW); f32x2* BBAR = (f32x2*)(ws + WS_BBAR); f32x2* ROPE = (f32x2*)(ws + WS_ROPE);
    const float *are = a.in[I_ARE], *aim = a.in[I_AIM], *ldt = a.in[I_LDT], *bre = a.in[I_BRE], *bim = a.in[I_BIM];
    for (int i = gt; i < 4096 * 65; i += GN) { const int s = i / 65, k = i - s * 65, gq = s >> 7, dir = (s >> 6) & 1, p = s & 63, idx = (dir * 32 + gq) * 64 + p;
        const double dt = exp((double)ldt[idx]); const double mag = exp((double)k * (double)are[idx] * dt); double sn, cs; sincos_big((double)k * (double)aim[idx] * dt, sn, cs);
        LPOW[i] = (f32x2){(float)(mag * cs), (float)(mag * sn)}; }
    for (int i = gt; i < 4096 * 16; i += GN) { const int s = i >> 4, hh = i & 15, gq = s >> 7, dir = (s >> 6) & 1, p = s & 63, idx = (dir * 32 + gq) * 64 + p;
        const double ar = are[idx], ai = aim[idx], dt = exp((double)ldt[idx]); const double mag = exp(ar * dt); double sn, cs; sincos_big(ai * dt, sn, cs);
        const cplx num = {mag * cs - 1.0, mag * sn}; const double den = ar * ar + ai * ai; const cplx coef = {(num.re * ar + num.im * ai) / den, (num.im * ar - num.re * ai) / den};
        const cplx b = {(double)bre[(size_t)idx * 16 + hh], (double)bim[(size_t)idx * 16 + hh]}; const cplx r = cmul(coef, b);
        BBAR[i] = (f32x2){(float)r.re, (float)r.im}; }
    for (int i = gt; i < 4096 * 32; i += GN) { const int pos = i >> 5, j = i & 31; const float inv = powf(10000.0f, -(float)j / 32.0f); const float ang = (float)pos * inv;
        double sn, cs; sincos_big((double)ang, sn, cs); ROPE[i] = (f32x2){(float)cs, (float)sn}; }
    if (gt == 0) { float s1 = 0.f, s2 = 0.f; for (int i = 0; i < 64; ++i) { s1 += a.in[I_LQ1][i] * a.in[I_LK1][i]; s2 += a.in[I_LQ2][i] * a.in[I_LK2][i]; }
        ((float*)(ws + WS_SCAL))[0] = expf(s1) - expf(s2) + 0.2f; }
}
__device__ __forceinline__ unsigned f2bf(float f) { unsigned u = __builtin_bit_cast(unsigned, f); return (u + 0x7fffu + ((u >> 16) & 1u)) >> 16; }
__device__ __forceinline__ unsigned pk2(float lo, float hi) { return f2bf(lo) | (f2bf(hi) << 16); }
__device__ __forceinline__ void tr_item(const float* W, int N, bf16_t* WT, int ldt, int k0, int n0, int drow0, const float* gain, LAS float* scr, int lane) {
#pragma unroll 8
    for (int i = 0; i < 32; ++i) { const int kk = 2 * i + (lane >> 5); float v = W[(size_t)(k0 + kk) * N + n0 + (lane & 31)]; if (gain) v *= gain[k0 + kk]; scr[kk * 33 + (lane & 31)] = v; }
    LDS_WAIT(); MEMFENCE();
    const int c = lane & 7;
#pragma unroll
    for (int j = 0; j < 4; ++j) { const int n = (lane >> 3) + 8 * j; const LAS float* s = scr + (8 * c) * 33 + n;
        u32x4 o; o.x = pk2(s[0 * 33], s[1 * 33]); o.y = pk2(s[2 * 33], s[3 * 33]); o.z = pk2(s[4 * 33], s[5 * 33]); o.w = pk2(s[6 * 33], s[7 * 33]);
        *(u32x4*)(WT + (size_t)(drow0 + n) * ldt + k0 + 8 * c) = o; }
    LDS_WAIT(); MEMFENCE();
}
__device__ __forceinline__ float wave_sum(float v) {
#pragma unroll
    for (int o = 1; o < 64; o <<= 1) v += __shfl_xor(v, o);
    return v;
}
__device__ __forceinline__ void phase_prep(const Args& a, unsigned char* ws, unsigned char* dob, LAS unsigned char* lds) {
    const int tid = tidx(), lane = tid & 63, wave = tid >> 6;
    const int gw = blockIdx.x * 8 + wave, NGW = gridDim.x * 8;
    const int gt = blockIdx.x * NTHR + tid, GN = gridDim.x * NTHR;
    LAS float* scr = (LAS float*)(lds + wave * 16384);
    constexpr int I_FF = 16 * 88, I_FD = 44 * 32, I_IN = 16 * 64, I_OUT = 16 * 32, I_GLU = 8 * 16;
    static_assert(I_FF == I_FD, "item counts");
    constexpr int NITEMS = 6 * I_FF + I_IN + I_OUT + I_GLU;
    for (int it = gw; it < NITEMS; it += NGW) {
        int r = it;
        if (r < 6 * I_FF) {
            const int blk = r / I_FF, layer = blk / 3, kind = blk % 3; r -= blk * I_FF;
            const float* gain = a.in[layer ? I_N2 : I_N1];
            if (kind < 2) { const int kb = r / 88, nb = r % 88, n0 = nb * 32; const int drow0 = 256 * (n0 >> 7) + 128 * kind + (n0 & 127);
                tr_item(a.in[(layer ? I_G2 : I_G1) + kind], DFF, (bf16_t*)(ws + (layer ? WS_W2 : WS_W1)), 1024, kb * 64, n0, drow0, gain, scr, lane); }
            else { const int kb = r / 32, nb = r % 32; tr_item(a.in[layer ? I_D2 : I_D1], 1024, (bf16_t*)(ws + (layer ? WS_W2D : WS_W1D)), DFF, kb * 64, nb * 32, nb * 32, nullptr, scr, lane); }
            continue;
        }
        r -= 6 * I_FF;
        if (r < I_IN) { const int kb = r / 64, nb = r % 64, n0 = nb * 32; int drow0 = n0;
            if (n0 < 1024) { const int L = n0 & 255; drow0 = (n0 & ~255) + ((L >> 5) & 1) * 128 + (L >> 6) * 32; }
            tr_item(a.in[I_WIN], 2048, (bf16_t*)(ws + WS_WIN), 1024, kb * 64, n0, drow0, a.in[I_MIXN], scr, lane); continue; }
        r -= I_IN;
        if (r < I_OUT) { const int kb = r / 32, nb = r % 32; tr_item(a.in[I_WOUT], 1024, (bf16_t*)(ws + WS_WOUT), 1024, kb * 64, nb * 32, nb * 32, nullptr, scr, lane); continue; }
        r -= I_OUT;
        { const int kb = r / 16, nb = r % 16; tr_item(a.in[I_WGLU], 512, (bf16_t*)(ws + WS_WGLU), 512, kb * 64, nb * 32, nb * 32, nullptr, scr, lane); }
    }
    const f32x2* LPOW = (const f32x2*)(dob + DO_LPOW); const f32x2* BBAR = (const f32x2*)(ws + WS_BBAR);
    const float *cre = a.in[I_CRE], *cim = a.in[I_CIM];
    float* KK = (float*)(dob + DO_KK);
    for (int i = gt; i < 32 * 2 * 64 * 16; i += GN) { const int ho = i & 15, k = (i >> 4) & 63, dir = (i >> 10) & 1, gq = i >> 11;
        const int s0 = (gq * 2 + dir) * 64; const size_t cb = ((size_t)(dir * 32 + gq) * 16 + ho) * 64;
        float accv[16];
#pragma unroll
        for (int e = 0; e < 16; ++e) accv[e] = 0.f;
        for (int p = 0; p < 64; ++p) { const f32x2 L = LPOW[(size_t)(s0 + p) * 65 + k]; const float cr = cre[cb + p], ci = cim[cb + p];
            const float tr = cr * L.x - ci * L.y, ti = cr * L.y + ci * L.x; const f32x2* bb = BBAR + (size_t)(s0 + p) * 16;
#pragma unroll
            for (int e = 0; e < 16; ++e) { const f32x2 b = bb[e]; accv[e] += tr * b.x - ti * b.y; } }
        if (dir == 0 && k == 0) accv[ho] += a.in[I_SSMD][gq * 16 + ho];
        float* dst = KK + (((size_t)(gq * 2 + dir) * 64 + k) * 16 + ho) * 16;
#pragma unroll
        for (int e = 0; e < 16; e += 4) *(f32x4*)(dst + e) = (f32x4){accv[e], accv[e + 1], accv[e + 2], accv[e + 3]}; }
    bf16_t* WSM = (bf16_t*)(dob + DO_WSM);
    for (int i = gt; i < 32 * 256 * 64 * 2; i += GN) { const int half = i & 1, ii = (i >> 1) & 63, n = (i >> 7) & 255, gq = i >> 15; const int dir = n >> 7, ri = (n >> 6) & 1, p = n & 63;
        const int s = (gq * 2 + dir) * 64 + p; const f32x2 L = LPOW[(size_t)s * 65 + (dir ? ii : 63 - ii)]; const f32x2* bb = BBAR + (size_t)s * 16 + half * 8;
        float v[8];
#pragma unroll
        for (int e = 0; e < 8; ++e) { const f32x2 b = bb[e]; v[e] = ri ? (L.x * b.y + L.y * b.x) : (L.x * b.x - L.y * b.y); }
        u32x4 w; w.x = pk2(v[0], v[1]); w.y = pk2(v[2], v[3]); w.z = pk2(v[4], v[5]); w.w = pk2(v[6], v[7]);
        *(u32x4*)(WSM + ((size_t)(gq * 256 + n)) * 1024 + ii * 16 + half * 8) = w; }
    bf16_t* BTY = (bf16_t*)(dob + DO_BTY);
    for (int i = gt; i < 32 * 1024 * 32; i += GN) { const int pb = i & 7, ri = (i >> 3) & 1, dir = (i >> 4) & 1, n = (i >> 5) & 1023, gq = i >> 15; const int j = n >> 4, ho = n & 15;
        const int s0 = (gq * 2 + dir) * 64 + pb * 8; const size_t cb = ((size_t)(dir * 32 + gq) * 16 + ho) * 64 + pb * 8; const int e = dir ? 64 - j : j + 1;
        float v[8];
#pragma unroll
        for (int q = 0; q < 8; ++q) { const f32x2 L = LPOW[(size_t)(s0 + q) * 65 + e]; const float cr = cre[cb + q], ci = cim[cb + q]; v[q] = ri ? -(cr * L.y + ci * L.x) : (cr * L.x - ci * L.y); }
        u32x4 w; w.x = pk2(v[0], v[1]); w.y = pk2(v[2], v[3]); w.z = pk2(v[4], v[5]); w.w = pk2(v[6], v[7]);
        *(u32x4*)(BTY + ((size_t)(gq * 1024 + n)) * LDU + 1024 + dir * 128 + ri * 64 + pb * 8) = w; }
    bf16_t* XB = (bf16_t*)(ws + WS_XB); float* SS = (float*)(ws + WS_SS);
    for (int m = gw; m < MT; m += NGW) {
        const float* xrow = m < MP ? a.in[I_XP] + (size_t)m * DM : a.in[I_XS] + (size_t)(m - MP) * DM;
        const f32x4* xr = (const f32x4*)xrow + lane; f32x4 v[4]; float s = 0.f;
#pragma unroll
        for (int j = 0; j < 4; ++j) { v[j] = xr[64 * j]; s += (v[j].x * v[j].x + v[j].y * v[j].y) + (v[j].z * v[j].z + v[j].w * v[j].w); }
        s = wave_sum(s);
        u32x2* o8 = (u32x2*)(XB + (size_t)m * DM) + lane;
#pragma unroll
        for (int j = 0; j < 4; ++j) o8[64 * j] = (u32x2){pk2(v[j].x, v[j].y), pk2(v[j].z, v[j].w)};
        if (lane < 2) SS[(size_t)(lane + 1) * MT + m] = 0.f;
        if (lane == 0) SS[m] = s;
    }
}
__device__ __forceinline__ void phase_toeplitz(unsigned char* dob) {
    const int gt = blockIdx.x * NTHR + tidx(), GN = gridDim.x * NTHR;
    const float* KK = (const float*)(dob + DO_KK); bf16_t* BTY = (bf16_t*)(dob + DO_BTY);
    for (int it = gt; it < 32 * 1024 * 128; it += GN) { const int half = it & 1, i = (it >> 1) & 63, n = (it >> 7) & 1023, gq = it >> 17; const int j = n >> 4, ho = n & 15;
        f32x4 v0 = {0.f, 0.f, 0.f, 0.f}, v1 = v0;
        if (j >= i) { const float* s = KK + (((size_t)(gq * 2 + 0) * 64 + (j - i)) * 16 + ho) * 16 + half * 8; v0 += *(const f32x4*)s; v1 += *(const f32x4*)(s + 4); }
        if (i >= j) { const float* s = KK + (((size_t)(gq * 2 + 1) * 64 + (i - j)) * 16 + ho) * 16 + half * 8; v0 += *(const f32x4*)s; v1 += *(const f32x4*)(s + 4); }
        u32x4 w; w.x = pk2(v0.x, v0.y); w.y = pk2(v0.z, v0.w); w.z = pk2(v1.x, v1.y); w.w = pk2(v1.z, v1.w);
        *(u32x4*)(BTY + ((size_t)(gq * 1024 + n)) * LDU + i * 16 + half * 8) = w; }
}
__device__ __forceinline__ void phase_chunkscan(unsigned char* ws, unsigned char* dob) {
    const int gt = blockIdx.x * NTHR + tidx(), GN = gridDim.x * NTHR;
    const f32x2* LPOW = (const f32x2*)(dob + DO_LPOW); const float* S = (const float*)(ws + WS_S); bf16_t* UH = (bf16_t*)(ws + WS_UH);
    for (int it = gt; it < 32 * 40 * 128; it += GN) { const int p = it & 63, dir = (it >> 6) & 1, rest = it >> 7, bt = rest % 40, gq = rest / 40;
        const int c0 = bt < 32 ? bt * 32 : 1024 + (bt - 32) * 64, nc = bt < 32 ? 32 : 64;
        const f32x2 L = LPOW[(size_t)((gq * 2 + dir) * 64 + p) * 65 + 64];
        float hr = 0.f, hi_ = 0.f;
        for (int cc = 0; cc < nc; ++cc) { const int c = dir ? nc - 1 - cc : cc; const size_t row = (size_t)gq * NCH + c0 + c;
            bf16_t* d = UH + row * LDU + 1024 + dir * 128 + p; d[0] = (bf16_t)f2bf(hr); d[64] = (bf16_t)f2bf(hi_);
            const float sr = S[row * 256 + dir * 128 + p], si = S[row * 256 + dir * 128 + 64 + p];
            const float nr = L.x * hr - L.y * hi_ + sr, ni = L.x * hi_ + L.y * hr + si; hr = nr; hi_ = ni; } }
}
__device__ __forceinline__ void phase_attn(const Args& a, unsigned char* ws, unsigned char* dob, char* lds) {
    const float lam = ((const float*)(ws + WS_SCAL))[0];
    const bf16_t* Q12 = (const bf16_t*)(ws + WS_Q12); const bf16_t* K12 = (const bf16_t*)(ws + WS_K12); const bf16_t* V = (const bf16_t*)(ws + WS_V); bf16_t* MIX = (bf16_t*)(dob + DO_MIX);
    for (int u = blockIdx.x; u < 1536; u += gridDim.x) {
        long row0; int seq, h, q0;
        if (u < 512) { const int i = u >> 8, cc = u & 255, x = cc & 7, j = cc >> 3; const int bh = (i * 8 + x) * 2 + (j >> 4), qb = j & 15; row0 = MP + (long)(bh >> 2) * LSM; seq = LSM; h = bh & 3; q0 = qb * 256; }
        else { const int v = u - 512, i = v >> 8, cc = v & 255, x = cc & 7, j = cc >> 3; const int bh = (i * 8 + x) * 4 + (j >> 3), qb = j & 7; row0 = (long)(bh >> 2) * LPR; seq = LPR; h = bh & 3; q0 = qb * 256; }
        att::attn_unit(Q12, K12, V, MIX, a.in[I_SUBN], lam, row0, seq, h, q0, lds);
    }
}
__device__ __forceinline__ void phase_final(const Args& a) {
    const int tid = tidx(), lane = tid & 63, gw = blockIdx.x * 8 + (tid >> 6), NGW = gridDim.x * 8;
    const f32x4* gp = (const f32x4*)a.in[I_FN] + lane; f32x4 gv[4];
#pragma unroll
    for (int j = 0; j < 4; ++j) gv[j] = gp[64 * j];
    for (int m = gw; m < MT; m += NGW) { f32x4* xr = (f32x4*)(a.out + (size_t)m * DM) + lane; f32x4 v[4]; float s = 0.f;
#pragma unroll
        for (int j = 0; j < 4; ++j) { v[j] = xr[64 * j]; s += (v[j].x * v[j].x + v[j].y * v[j].y) + (v[j].z * v[j].z + v[j].w * v[j].w); }
        const float ri = rsqrtf(wave_sum(s) * (1.0f / 1024.0f) + 1e-6f);
#pragma unroll
        for (int j = 0; j < 4; ++j) xr[64 * j] = v[j] * ri * gv[j]; }
}

__global__ void __launch_bounds__(NTHR, 2) fwd_kernel(Args a) {
    extern __shared__ __attribute__((aligned(16))) unsigned char lds[];
    LAS unsigned char* L3 = (LAS unsigned char*)lds;
    unsigned char* ws = a.ws; unsigned char* dob = (unsigned char*)a.out;
    const int G = gridDim.x, lo = a.ph_lo, hi = a.ph_hi;
#ifndef ONLY_PHASE
#define ONLY_PHASE -1
#endif
#define IN(k) ((ONLY_PHASE < 0 || ONLY_PHASE == (k)) && lo <= (k) && (k) < hi)
#if MK_MULTI
#define SEAM(k) do { } while (0)
#else
#define SEAM(k) do { if (IN(k) && IN((k) + 1)) { cg::this_grid().sync(); } } while (0)
#endif
    bf16_t* XB = (bf16_t*)(ws + WS_XB); bf16_t* H = (bf16_t*)(ws + WS_H); float* SS = (float*)(ws + WS_SS);
    pg8::StaticOrder S;
#define REPS(k) for (int rep_ = 0; rep_ < ((PROBE_PHASE == (k)) ? 2 : 1); ++rep_)
#define RSYNC() do { if (rep_) cg::this_grid().sync(); } while (0)
    if (IN(0)) REPS(0) { RSYNC(); phase_tables(a, ws, dob); } SEAM(0);
    if (IN(1)) REPS(1) { RSYNC(); phase_prep(a, ws, dob, L3); __syncthreads(); } SEAM(1);
    if (IN(2)) REPS(2) { RSYNC();
        phase_toeplitz(dob);
        pg8::Gemm g{XB, (const bf16_t*)(ws + WS_W1), MT, 2 * DFF, 1024, 1024, 1024, 0, 0}; S.init(MT, 2 * DFF, G, (int)blockIdx.x);
        pg8::EpiSwiGLU E{H, SS}; pg8::gemm_phase(L3, g, S, E);
    } SEAM(2);
    if (IN(3)) REPS(3) { RSYNC();
        pg8::Gemm g{H, (const bf16_t*)(ws + WS_W1D), MT, 1024, DFF, DFF, DFF, 0, 0}; S.init(MT, 1024, G, (int)blockIdx.x);
        pg8::EpiRes<false> E{a.in[I_XP], a.in[I_XS], nullptr, 0.5f, nullptr, XB, SS + MT}; pg8::gemm_phase(L3, g, S, E);
    } SEAM(3);
    if (IN(4)) REPS(4) { RSYNC();
        pg8::Gemm g{XB, (const bf16_t*)(ws + WS_WIN), MT, 2048, 1024, 1024, 1024, 0, 0}; S.init(MT, 2048, G, (int)blockIdx.x);
        pg8::EpiProj E{SS + MT, (const f32x4*)(ws + WS_ROPE), (bf16_t*)(ws + WS_Q12), (bf16_t*)(ws + WS_K12), (bf16_t*)(ws + WS_V), (bf16_t*)(ws + WS_UH)}; pg8::gemm_phase(L3, g, S, E);
    } SEAM(4);
    if (IN(5)) REPS(5) { RSYNC();
        pg8::Gemm g{(const bf16_t*)(ws + WS_UH), (const bf16_t*)(dob + DO_WSM), MG, 256, 1024, LDU, 1024, 6, 1}; S.init(MG, 256, G, (int)blockIdx.x);
        pg8::EpiS E{(float*)(ws + WS_S)}; pg8::gemm_phase(L3, g, S, E);
    } SEAM(5);
    if (IN(6)) REPS(6) { RSYNC(); phase_chunkscan(ws, dob); phase_attn(a, ws, dob, (char*)lds); } SEAM(6);
    if (IN(7)) REPS(7) { RSYNC();
        pg8::Gemm g{(const bf16_t*)(ws + WS_UH), (const bf16_t*)(dob + DO_BTY), MG, 1024, LDU, LDU, LDU, 6, 4}; S.init(MG, 1024, G, (int)blockIdx.x);
        pg8::EpiY E{(bf16_t*)(ws + WS_Q12)}; pg8::gemm_phase(L3, g, S, E);
    } SEAM(7);
    if (IN(8)) REPS(8) { RSYNC();
        pg8::Gemm g{(const bf16_t*)(ws + WS_Q12), (const bf16_t*)(ws + WS_WGLU), MT, 512, 512, 512, 512, 0, 0}; S.init(MT, 512, G, (int)blockIdx.x);
        pg8::EpiGLU E{(const bf16_t*)(ws + WS_Q12), (bf16_t*)(dob + DO_MIX)}; pg8::gemm_phase(L3, g, S, E);
    } SEAM(8);
    if (IN(9)) REPS(9) { RSYNC();
        pg8::Gemm g{(const bf16_t*)(dob + DO_MIX), (const bf16_t*)(ws + WS_WOUT), MT, 1024, 1024, 1024, 1024, 0, 0}; S.init(MT, 1024, G, (int)blockIdx.x);
        pg8::EpiRes<true> E{nullptr, nullptr, XB, 1.0f, nullptr, XB, SS + 2 * MT}; pg8::gemm_phase(L3, g, S, E);
    } SEAM(9);
    if (IN(10)) REPS(10) { RSYNC();
        pg8::Gemm g{XB, (const bf16_t*)(ws + WS_W2), MT, 2 * DFF, 1024, 1024, 1024, 0, 0}; S.init(MT, 2 * DFF, G, (int)blockIdx.x);
        pg8::EpiSwiGLU E{H, SS + 2 * MT}; pg8::gemm_phase(L3, g, S, E);
    } SEAM(10);
    if (IN(11)) REPS(11) { RSYNC();
        pg8::Gemm g{H, (const bf16_t*)(ws + WS_W2D), MT, 1024, DFF, DFF, DFF, 0, 0}; S.init(MT, 1024, G, (int)blockIdx.x);
        pg8::EpiRes<true> E{nullptr, nullptr, XB, 0.5f, a.out, nullptr, nullptr}; pg8::gemm_phase(L3, g, S, E);
    } SEAM(11);
    if (IN(12)) { phase_final(a); }
#undef IN
#undef SEAM
}

extern "C" void kernel_launch(void* const* d_in, const int* in_sizes, int n_in, void* d_out, int out_size, void* d_ws, size_t ws_size, hipStream_t stream) {
    static int grid = 0;
    if (grid == 0) {
        if (n_in != 28 || in_sizes[0] != MP * DM || out_size != MT * DM || ws_size < WS_END) { fprintf(stderr, "kernel_launch: unexpected shapes n_in %d in0 %d out %d ws %zu\n", n_in, n_in > 0 ? in_sizes[0] : -1, out_size, ws_size); grid = -1; return; }
        int dev = 0, cus = 0, per_cu = 0;
        hipGetDevice(&dev); hipDeviceGetAttribute(&cus, hipDeviceAttributeMultiprocessorCount, dev);
        if (hipFuncSetAttribute((const void*)fwd_kernel, hipFuncAttributeMaxDynamicSharedMemorySize, LDS_BYTES) != hipSuccess) { fprintf(stderr, "kernel_launch: hipFuncSetAttribute failed\n"); grid = -1; return; }
        if (hipOccupancyMaxActiveBlocksPerMultiprocessor(&per_cu, (const void*)fwd_kernel, NTHR, LDS_BYTES) != hipSuccess || per_cu < 1) { fprintf(stderr, "kernel_launch: occupancy query says %d\n", per_cu); per_cu = 1; }
        (void)hipGetLastError();
        grid = cus * 1;
    }
    if (grid < 0) return;
    Args a{};
    for (int i = 0; i < 28; ++i) a.in[i] = (const float*)d_in[i];
    a.out = (float*)d_out; a.ws = (unsigned char*)d_ws;
#if MK_MULTI
    for (int p = 0; p < NPHASE; ++p) { a.ph_lo = p; a.ph_hi = p + 1; hipLaunchKernelGGL(fwd_kernel, dim3(grid), dim3(NTHR), LDS_BYTES, stream, a); }
#else
    a.ph_lo = 0; a.ph_hi = NPHASE;
    void* args[] = {&a};
    hipError_t e = hipLaunchCooperativeKernel((const void*)fwd_kernel, dim3(grid), dim3(NTHR), args, LDS_BYTES, stream);
    if (e != hipSuccess) fprintf(stderr, "kernel_launch: cooperative launch failed: %s (grid %d)\n", hipGetErrorString(e), grid);
#endif
}
```

```cpp
#include <hip/hip_runtime.h>
#include <hip/hip_cooperative_groups.h>
#include <cstdio>
#include <cstdint>
namespace cg = cooperative_groups;

#ifndef MK_MULTI
#define MK_MULTI 0
#endif

#ifndef PROBE_PHASE
#define PROBE_PHASE -1
#endif
#define LAS __attribute__((address_space(3)))
#define GAS __attribute__((address_space(1)))
typedef unsigned short bf16_t;
typedef short bf16x8 __attribute__((ext_vector_type(8)));
typedef short s16x4 __attribute__((ext_vector_type(4)));
typedef float f32x4 __attribute__((ext_vector_type(4)));
typedef float f32x2 __attribute__((ext_vector_type(2)));
typedef float f32x16 __attribute__((ext_vector_type(16)));
typedef unsigned u32x4 __attribute__((ext_vector_type(4)));
typedef unsigned u32x2 __attribute__((ext_vector_type(2)));

constexpr int DM = 1024, MP = 65536, MT = 98304, LPR = 2048, LSM = 4096, DFF = 2816;
constexpr int NCH = MT / 64;
constexpr int MG = 32 * NCH;
constexpr int LDU = 1280;
constexpr int LDH = DFF + 64;
constexpr float C2 = 0.125f * 1.4426950408889634f;
constexpr float LOG2E = 1.4426950408889634f;

constexpr size_t MiB = (size_t)1 << 20;
constexpr size_t WS_XB = 0;
constexpr size_t WS_H = 192 * MiB;
constexpr size_t WS_Q12 = 192 * MiB;
constexpr size_t WS_K12 = 288 * MiB;
constexpr size_t WS_V = 384 * MiB;
constexpr size_t WS_UH = 480 * MiB;
constexpr size_t WS_S = 600 * MiB;
constexpr size_t WS_W1 = 732 * MiB, WS_W1D = 743 * MiB, WS_WIN = 749 * MiB, WS_WOUT = 753 * MiB, WS_WGLU = 755 * MiB, WS_W2 = 756 * MiB, WS_W2D = 767 * MiB;
constexpr size_t WS_SS = 773 * MiB;
constexpr size_t WS_ROPE = 779 * MiB;
constexpr size_t WS_BBAR = 780 * MiB;
constexpr size_t WS_SCAL = 781 * MiB;
constexpr size_t WS_BAR = 782 * MiB;
constexpr size_t WS_END = 783 * MiB;
constexpr size_t DO_MIX = 0;
constexpr size_t DO_BTY = 192 * MiB;
constexpr size_t DO_WSM = 272 * MiB;
constexpr size_t DO_LPOW = 288 * MiB;
constexpr size_t DO_KK = 292 * MiB;

#define LDS_WAIT() asm volatile("s_waitcnt lgkmcnt(0)" ::: "memory")
#define VM_WAIT() asm volatile("s_waitcnt vmcnt(0)" ::: "memory")
#define MEMFENCE() asm volatile("" ::: "memory")

__device__ __forceinline__ int lane_id() { return (int)__builtin_amdgcn_mbcnt_hi(~0u, __builtin_amdgcn_mbcnt_lo(~0u, 0u)); }
__device__ __forceinline__ int tidx(int wv) { int t = (wv << 6) | lane_id(); asm volatile("" : "+v"(t)); return t; }
__device__ __forceinline__ unsigned cvt_pk_bf16(float lo, float hi) { unsigned r; asm volatile("v_cvt_pk_bf16_f32 %0, %1, %2" : "=v"(r) : "v"(lo), "v"(hi)); return r; }
__device__ __forceinline__ float bf_lo(unsigned w) { return __uint_as_float(w << 16); }
__device__ __forceinline__ float bf_hi(unsigned w) { return __uint_as_float(w & 0xffff0000u); }
__device__ __forceinline__ float fast_rcp(float x) { return __builtin_amdgcn_rcpf(x); }
__device__ __forceinline__ float fast_exp2(float x) { return __builtin_amdgcn_exp2f(x); }
__device__ __forceinline__ float rinv_of(const float* ss, int row) { return rsqrtf(ss[row] * (1.0f / 1024.0f) + 1e-6f); }

namespace pg8 {
constexpr int BM = 256, BK = 64, HALF = 128, HTB = HALF * BK * 2, STAGE_BYTES = 8 * HTB, NXCD = 8, WGM = 8;
__host__ __device__ __forceinline__ int lds_byte(int r, int c) { const int st = (r >> 4) * 2 + (c >> 5), rr = r & 15, cc = c & 31, ob = rr * 64 + cc * 2; return st * 1024 + (ob ^ (((ob >> 9) & 1) << 5)); }
__host__ __device__ __forceinline__ void stage_rc(int b, int& R, int& C) { const int st = b / 1024, sb = b % 1024, swz = sb ^ (((sb >> 9) & 1) << 5); R = (st >> 1) * 16 + swz / 64; C = (st & 1) * 32 + (swz % 64) / 2; }
__host__ __device__ __forceinline__ int perm32(int rho) { const int n = rho >> 4, i = rho & 15; return 8 * (i >> 2) + 4 * n + (i & 3); }
struct Unit { int pm, pn; };
struct Gemm { const bf16_t* A; const bf16_t* Bt; int M, N, K, lda, ldb, gdiv, gtiles; };
struct StaticOrder {
    int nM, nN, nwg, G, c;
    __device__ void init(int M, int N, int G_, int c_) { nM = M / BM; nN = N / BM; nwg = nM * nN; G = G_; c = c_; }
    __device__ bool next(int i, Unit& u) const {
        const long L = (long)i * G + c; if (L >= nwg) return false;
        int wgid = (int)L; { const int q = nwg / NXCD, r = nwg % NXCD, xcd = wgid % NXCD, off = wgid / NXCD; wgid = (xcd < r ? xcd * (q + 1) : r * (q + 1) + (xcd - r) * q) + off; }
        const int nig = WGM * nN, gid = wgid / nig, fm = gid * WGM, gsz = (nM - fm) < WGM ? (nM - fm) : WGM;
        u.pm = fm + ((wgid % nig) % gsz); u.pn = (wgid % nig) / gsz; return true;
    }
};
template <class Epi>
__device__ __forceinline__ void gemm_phase(LAS unsigned char* lds, const Gemm g, const StaticOrder& S, const Epi& E, int wv, int stagger_us = 0) {
    if (stagger_us) { const unsigned long long t0 = __builtin_amdgcn_s_memrealtime(), dl = (unsigned long long)(((blockIdx.x >> 3) & 3) * stagger_us * 25);
        while (__builtin_amdgcn_s_memrealtime() - t0 < dl) __builtin_amdgcn_s_sleep(8); }
    const int tid = tidx(wv), wid = __builtin_amdgcn_readfirstlane(tid >> 6), lane = tid & 63, wr = wid >> 2, wc = wid & 3, fr = lane & 15, fq = lane >> 4;
    const int K = g.K, nt = K / BK;
    unsigned voffA[2], voffB[2];
#pragma unroll
    for (int i = 0; i < 2; ++i) { int R, C; stage_rc(tid * 16 + i * 8192, R, C); const int Rb = (R & ~31) + perm32(R & 31);
        voffA[i] = (unsigned)(R * g.lda + C) * 2u; voffB[i] = (unsigned)(Rb * g.ldb + C) * 2u; }
    const size_t kstep = (size_t)(BK * 2);
    const size_t hstepA = (size_t)HALF * g.lda * 2, hstepB = (size_t)HALF * g.ldb * 2;
    const size_t tstepA = 2 * hstepA, tstepB = 2 * hstepB;
    const unsigned ldsw = (unsigned)wid * 1024u;
    const int aoff = lds_byte(wr * 64 + fr, fq * 8), boff = lds_byte(wc * 32 + fr, fq * 8);
#define PG8_BT(u) ((u).pn + (g.gdiv ? ((u).pm / g.gdiv) * g.gtiles : 0))
#define PG8_SA(b, h) (((b) * 2 + (h)) * HTB)
#define PG8_SB(b, h) ((4 + (b) * 2 + (h)) * HTB)
#define PG8_STAGE(bufoff, gbase, voff) do { _Pragma("unroll") for (int _i = 0; _i < 2; ++_i) \
        __builtin_amdgcn_global_load_lds((const unsigned*)((const char*)(gbase) + (voff)[_i]), (LAS unsigned*)(lds + (bufoff) + ldsw + _i * 8192), 16, 0, 0); } while (0)
#define PG8_LDA(dst, b, h) do { _Pragma("unroll") for (int m = 0; m < 4; ++m) _Pragma("unroll") for (int k = 0; k < 2; ++k) dst[m][k] = *(const LAS bf16x8*)(lds + PG8_SA(b, h) + aoff + m * 2048 + k * 1024); } while (0)
#define PG8_LDB(dst, b, h) do { _Pragma("unroll") for (int n = 0; n < 2; ++n) _Pragma("unroll") for (int k = 0; k < 2; ++k) dst[n][k] = *(const LAS bf16x8*)(lds + PG8_SB(b, h) + boff + n * 2048 + k * 1024); } while (0)
#define PG8_MMA(ai, bj, At, Bt) do { __builtin_amdgcn_s_setprio(1); _Pragma("unroll") for (int m = 0; m < 4; ++m) _Pragma("unroll") for (int n = 0; n < 2; ++n) _Pragma("unroll") for (int k = 0; k < 2; ++k) \
        acc[ai][bj][m][n] = __builtin_amdgcn_mfma_f32_16x16x32_bf16(Bt[n][k], At[m][k], acc[ai][bj][m][n], 0, 0, 0); __builtin_amdgcn_s_setprio(0); } while (0)
#define PG8_WAIT_V(n) asm volatile("s_waitcnt vmcnt(" #n ")" ::: "memory")
#define PG8_WAIT_L(n) asm volatile("s_waitcnt lgkmcnt(" #n ")" ::: "memory")
#define PG8_BAR __builtin_amdgcn_s_barrier()
#define PG8_SCHED __builtin_amdgcn_sched_barrier(0)
    Unit cur, nxt; int ui = 0;
    if (!S.next(0, cur)) return;
    f32x4 acc[2][2][4][2];
#pragma unroll
    for (int a = 0; a < 2; ++a)
#pragma unroll
        for (int b = 0; b < 2; ++b)
#pragma unroll
            for (int m = 0; m < 4; ++m)
#pragma unroll
                for (int n = 0; n < 2; ++n) acc[a][b][m][n] = (f32x4){0.f, 0.f, 0.f, 0.f};
    bf16x8 At[4][2], B0[2][2], B1[2][2];
    const char* cA = (const char*)g.A + (size_t)cur.pm * tstepA; const char* cB = (const char*)g.Bt + (size_t)PG8_BT(cur) * tstepB;
    PG8_STAGE(PG8_SB(0, 0), cB, voffB); PG8_STAGE(PG8_SB(0, 1), cB + hstepB, voffB); PG8_STAGE(PG8_SA(0, 0), cA, voffA); PG8_STAGE(PG8_SA(0, 1), cA + hstepA, voffA);
    PG8_STAGE(PG8_SB(1, 0), cB + kstep, voffB); PG8_STAGE(PG8_SA(1, 0), cA + kstep, voffA); PG8_STAGE(PG8_SB(1, 1), cB + hstepB + kstep, voffB);
    if (wr == 1) PG8_BAR;
    PG8_WAIT_V(8); PG8_BAR;
    PG8_WAIT_V(6); PG8_BAR;
    for (;;) {
        const bool has_next = S.next(ui + 1, nxt);
        const char* nA = has_next ? (const char*)g.A + (size_t)nxt.pm * tstepA : cA; const char* nB = has_next ? (const char*)g.Bt + (size_t)PG8_BT(nxt) * tstepB : cB;
        typename Epi::Pre pre; E.prefetch(pre, cur, wr, fr);
        for (int t = 0; t < nt; t += 2) {
            const bool last = (t == nt - 2);
            const char* a1 = cA + (size_t)(t + 1) * kstep;
            const char* a2 = last ? nA : cA + (size_t)(t + 2) * kstep; const char* b2 = last ? nB : cB + (size_t)(t + 2) * kstep;
            const char* a3 = a2 + kstep; const char* b3 = b2 + kstep;
            PG8_LDB(B0, 0, 0); PG8_LDB(B1, 0, 1); PG8_SCHED; PG8_LDA(At, 0, 0); PG8_STAGE(PG8_SA(1, 1), a1 + hstepA, voffA);
            PG8_WAIT_V(8); PG8_WAIT_L(0); PG8_BAR; PG8_MMA(0, 0, At, B0); PG8_MMA(0, 1, At, B1); PG8_BAR; PG8_SCHED;
            PG8_LDA(At, 0, 1); PG8_STAGE(PG8_SB(0, 0), b2, voffB); PG8_STAGE(PG8_SB(0, 1), b2 + hstepB, voffB); PG8_STAGE(PG8_SA(0, 0), a2, voffA);
            PG8_WAIT_V(8); PG8_WAIT_L(0); PG8_BAR; PG8_MMA(1, 0, At, B0); PG8_MMA(1, 1, At, B1); PG8_BAR; PG8_SCHED;
            PG8_LDB(B0, 1, 0); PG8_LDB(B1, 1, 1); PG8_SCHED; PG8_LDA(At, 1, 0); PG8_STAGE(PG8_SA(0, 1), a2 + hstepA, voffA);
            PG8_WAIT_V(8); PG8_WAIT_L(0); PG8_BAR; PG8_MMA(0, 0, At, B0); PG8_MMA(0, 1, At, B1); PG8_BAR; PG8_SCHED;
            PG8_LDA(At, 1, 1); PG8_STAGE(PG8_SB(1, 0), b3, voffB); PG8_STAGE(PG8_SB(1, 1), b3 + hstepB, voffB); PG8_STAGE(PG8_SA(1, 0), a3, voffA);
            PG8_WAIT_V(8); PG8_WAIT_L(0); PG8_BAR; PG8_MMA(1, 0, At, B0); PG8_MMA(1, 1, At, B1); PG8_BAR; PG8_SCHED;
        }
        if (wr == 0) PG8_BAR;
        E(acc, pre, cur, wr, wc, fr, fq);
        if (!has_next) break;
#pragma unroll
        for (int a = 0; a < 2; ++a)
#pragma unroll
            for (int b = 0; b < 2; ++b)
#pragma unroll
                for (int m = 0; m < 4; ++m)
#pragma unroll
                    for (int n = 0; n < 2; ++n) acc[a][b][m][n] = (f32x4){0.f, 0.f, 0.f, 0.f};
        cur = nxt; cA = nA; cB = nB; ++ui;
        if (wr == 1) PG8_BAR;
    }
    PG8_WAIT_V(0);
    PG8_BAR;
#undef PG8_BT
#undef PG8_SA
#undef PG8_SB
#undef PG8_STAGE
#undef PG8_LDA
#undef PG8_LDB
#undef PG8_MMA
#undef PG8_WAIT_V
#undef PG8_WAIT_L
#undef PG8_BAR
#undef PG8_SCHED
}

typedef f32x4 Acc[2][2][4][2];

struct EpiSwiGLU {
    bf16_t* H; const float* ss;
    struct Pre { float rv[2][4]; };
    __device__ __forceinline__ void prefetch(Pre& p, const Unit& u, int wr, int fr) const {
#pragma unroll
        for (int ai = 0; ai < 2; ++ai)
#pragma unroll
            for (int m = 0; m < 4; ++m) p.rv[ai][m] = ss[u.pm * BM + wr * 64 + fr + ai * HALF + m * 16];
    }
    __device__ __forceinline__ void operator()(const Acc& acc, const Pre& pre, const Unit& u, int wr, int wc, int fr, int fq) const {
        const int row0 = u.pm * BM + wr * 64 + fr, col0 = u.pn * 128 + wc * 32 + 8 * fq;
#pragma unroll
        for (int ai = 0; ai < 2; ++ai)
#pragma unroll
            for (int m = 0; m < 4; ++m) {
                const int row = row0 + ai * HALF + m * 16; const float var = pre.rv[ai][m] * (1.0f / 1024.0f) + 1e-6f, nl = -rsqrtf(var) * LOG2E;
                float hv[8];
#pragma unroll
                for (int n = 0; n < 2; ++n)
#pragma unroll
                    for (int j = 0; j < 4; ++j) { const float gacc = acc[ai][0][m][n][j], uacc = acc[ai][1][m][n][j]; const float e = fast_exp2(gacc * nl);
                        hv[n * 4 + j] = (gacc * uacc) * fast_rcp(fmaf(e, var, var)); }
                u32x4 w; w.x = cvt_pk_bf16(hv[0], hv[1]); w.y = cvt_pk_bf16(hv[2], hv[3]); w.z = cvt_pk_bf16(hv[4], hv[5]); w.w = cvt_pk_bf16(hv[6], hv[7]);
                *(u32x4*)(H + (size_t)row * LDH + col0) = w;
            }
    }
};
template <bool B16> struct EpiRes {
    const float* baseP; const float* baseS; const bf16_t* base16; float alpha; float* out32; bf16_t* out16; float* ss;
    struct Pre {}; __device__ __forceinline__ void prefetch(Pre&, const Unit&, int, int) const {}
    __device__ __forceinline__ void operator()(const Acc& acc, const Pre& pre, const Unit& u, int wr, int wc, int fr, int fq) const {
        const int row0 = u.pm * BM + wr * 64 + fr;
        const GAS float* b32 = (u.pm < MP / BM) ? (const GAS float*)baseP : (const GAS float*)baseS - (size_t)MP * DM;
        u32x4 p16[2][4][2];
        if (B16) {
#pragma unroll
            for (int ai = 0; ai < 2; ++ai)
#pragma unroll
                for (int m = 0; m < 4; ++m)
#pragma unroll
                    for (int bj = 0; bj < 2; ++bj) p16[ai][m][bj] = *(const u32x4*)(base16 + (size_t)(row0 + ai * HALF + m * 16) * DM + u.pn * BM + bj * HALF + wc * 32 + 8 * fq);
        }
#pragma unroll
        for (int ai = 0; ai < 2; ++ai) {
            f32x4 p32[4][2][2];
            if (!B16) {
#pragma unroll
                for (int m = 0; m < 4; ++m)
#pragma unroll
                    for (int bj = 0; bj < 2; ++bj) { const size_t off = (size_t)(row0 + ai * HALF + m * 16) * DM + u.pn * BM + bj * HALF + wc * 32 + 8 * fq;
                        p32[m][bj][0] = *(const GAS f32x4*)(b32 + off); p32[m][bj][1] = *(const GAS f32x4*)(b32 + off + 4); }
            }
#pragma unroll
            for (int m = 0; m < 4; ++m) {
                const int row = row0 + ai * HALF + m * 16; float sq = 0.f;
#pragma unroll
                for (int bj = 0; bj < 2; ++bj) {
                    const size_t off = (size_t)row * DM + u.pn * BM + bj * HALF + wc * 32 + 8 * fq;
                    f32x4 b0, b1;
                    if (B16) { const u32x4 w = p16[ai][m][bj]; b0 = (f32x4){bf_lo(w.x), bf_hi(w.x), bf_lo(w.y), bf_hi(w.y)}; b1 = (f32x4){bf_lo(w.z), bf_hi(w.z), bf_lo(w.w), bf_hi(w.w)}; }
                    else { b0 = p32[m][bj][0]; b1 = p32[m][bj][1]; }
                    const f32x4 v0 = b0 + acc[ai][bj][m][0] * alpha, v1 = b1 + acc[ai][bj][m][1] * alpha;
                    sq += (v0.x * v0.x + v0.y * v0.y) + (v0.z * v0.z + v0.w * v0.w) + (v1.x * v1.x + v1.y * v1.y) + (v1.z * v1.z + v1.w * v1.w);
                    if (out32) { *(f32x4*)(out32 + off) = v0; *(f32x4*)(out32 + off + 4) = v1; }
                    if (out16) { u32x4 w; w.x = cvt_pk_bf16(v0.x, v0.y); w.y = cvt_pk_bf16(v0.z, v0.w); w.z = cvt_pk_bf16(v1.x, v1.y); w.w = cvt_pk_bf16(v1.z, v1.w); *(u32x4*)(out16 + off) = w; }
                }
                if (ss) { sq += __shfl_xor(sq, 16); sq += __shfl_xor(sq, 32); if (fq == 0) __hip_atomic_fetch_add(ss + row, sq, __ATOMIC_RELAXED, __HIP_MEMORY_SCOPE_AGENT); }
            }
            if (!B16) MEMFENCE();
        }
    }
};
struct EpiProj {
    const float* ss; const f32x4* rope; bf16_t *Q12, *K12, *V, *UH;
    struct Pre { float rv[2][4]; };
    __device__ __forceinline__ void prefetch(Pre& p, const Unit& u, int wr, int fr) const {
#pragma unroll
        for (int ai = 0; ai < 2; ++ai)
#pragma unroll
            for (int m = 0; m < 4; ++m) p.rv[ai][m] = ss[u.pm * BM + wr * 64 + fr + ai * HALF + m * 16];
    }
    __device__ __forceinline__ void operator()(const Acc& acc, const Pre& pre, const Unit& u, int wr, int wc, int fr, int fq) const {
        const int row0 = u.pm * BM + wr * 64 + fr; const int pn = u.pn;
#pragma unroll
        for (int am = 0; am < 4; ++am) {
            const int ai = am >> 1;
            f32x4 rp[2][4];
            if (pn < 4) {
#pragma unroll
                for (int mm = 0; mm < 2; ++mm) { const int m = (am & 1) * 2 + mm; const int row = row0 + ai * HALF + m * 16; const int pos = row < MP ? (row & (LPR - 1)) : ((row - MP) & (LSM - 1));
                    const f32x4* p = rope + (size_t)pos * 16 + 4 * fq;
#pragma unroll
                    for (int q = 0; q < 4; ++q) rp[mm][q] = p[q]; }
            }
#pragma unroll
            for (int mm = 0; mm < 2; ++mm) {
                const int m = (am & 1) * 2 + mm;
                const int row = row0 + ai * HALF + m * 16; const float ri = rsqrtf(pre.rv[ai][m] * (1.0f / 1024.0f) + 1e-6f);
                if (pn < 4) {
                    const float sc = (pn < 2 ? C2 : 1.0f) * ri;
                    float o1[8], o2[8];
#pragma unroll
                    for (int q = 0; q < 4; ++q) { const f32x4 cs = rp[mm][q];
                        { const int e = 2 * q; const float x1 = acc[ai][0][m][e >> 2][e & 3] * sc, x2 = acc[ai][1][m][e >> 2][e & 3] * sc; o1[e] = x1 * cs.x - x2 * cs.y; o2[e] = x2 * cs.x + x1 * cs.y; }
                        { const int e = 2 * q + 1; const float x1 = acc[ai][0][m][e >> 2][e & 3] * sc, x2 = acc[ai][1][m][e >> 2][e & 3] * sc; o1[e] = x1 * cs.z - x2 * cs.w; o2[e] = x2 * cs.z + x1 * cs.w; } }
                    bf16_t* dst = (pn < 2 ? Q12 : K12) + (size_t)row * 512 + (pn & 1) * 256 + wc * 64 + 8 * fq;
                    u32x4 w; w.x = cvt_pk_bf16(o1[0], o1[1]); w.y = cvt_pk_bf16(o1[2], o1[3]); w.z = cvt_pk_bf16(o1[4], o1[5]); w.w = cvt_pk_bf16(o1[6], o1[7]); *(u32x4*)dst = w;
                    w.x = cvt_pk_bf16(o2[0], o2[1]); w.y = cvt_pk_bf16(o2[2], o2[3]); w.z = cvt_pk_bf16(o2[4], o2[5]); w.w = cvt_pk_bf16(o2[6], o2[7]); *(u32x4*)(dst + 32) = w;
                } else {
#pragma unroll
                    for (int bj = 0; bj < 2; ++bj) {
                        const f32x4 v0 = acc[ai][bj][m][0] * ri, v1 = acc[ai][bj][m][1] * ri;
                        u32x4 w; w.x = cvt_pk_bf16(v0.x, v0.y); w.y = cvt_pk_bf16(v0.z, v0.w); w.z = cvt_pk_bf16(v1.x, v1.y); w.w = cvt_pk_bf16(v1.z, v1.w);
                        const int c0 = (pn & 1) * 256 + bj * HALF + wc * 32 + 8 * fq;
                        if (pn < 6) *(u32x4*)(V + (size_t)row * 512 + c0) = w;
                        else { const int gq = c0 >> 4, hi0 = c0 & 15; *(u32x4*)(UH + ((size_t)gq * NCH + (row >> 6)) * LDU + (row & 63) * 16 + hi0) = w; }
                    }
                }
            }
            MEMFENCE();
        }
    }
};
struct EpiS {
    float* S;
    struct Pre {}; __device__ __forceinline__ void prefetch(Pre&, const Unit&, int, int) const {}
    __device__ __forceinline__ void operator()(const Acc& acc, const Pre& pre, const Unit& u, int wr, int wc, int fr, int fq) const {
        const int row0 = u.pm * BM + wr * 64 + fr;
#pragma unroll
        for (int ai = 0; ai < 2; ++ai)
#pragma unroll
            for (int m = 0; m < 4; ++m) { const int row = row0 + ai * HALF + m * 16;
#pragma unroll
                for (int bj = 0; bj < 2; ++bj) { float* p = S + (size_t)row * 256 + bj * HALF + wc * 32 + 8 * fq; *(f32x4*)p = acc[ai][bj][m][0]; *(f32x4*)(p + 4) = acc[ai][bj][m][1]; } }
    }
};
struct EpiY {
    bf16_t* SG;
    struct Pre {}; __device__ __forceinline__ void prefetch(Pre&, const Unit&, int, int) const {}
    __device__ __forceinline__ void operator()(const Acc& acc, const Pre& pre, const Unit& u, int wr, int wc, int fr, int fq) const {
        const int row0 = u.pm * BM + wr * 64 + fr;
#pragma unroll
        for (int ai = 0; ai < 2; ++ai)
#pragma unroll
            for (int m = 0; m < 4; ++m) { const int row = row0 + ai * HALF + m * 16; const int gq = row / NCH, ch = row - gq * NCH;
#pragma unroll
                for (int bj = 0; bj < 2; ++bj) {
                    const int c0 = u.pn * BM + bj * HALF + wc * 32 + 8 * fq, j = c0 >> 4, ho0 = c0 & 15;
                    float hv[8];
#pragma unroll
                    for (int e = 0; e < 8; ++e) { const float y = acc[ai][bj][m][e >> 2][e & 3]; const float z = 1.5957691216057308f * (y + 0.044715f * y * y * y);
                        hv[e] = y * fast_rcp(1.0f + fast_exp2(-z * LOG2E)); }
                    u32x4 w; w.x = cvt_pk_bf16(hv[0], hv[1]); w.y = cvt_pk_bf16(hv[2], hv[3]); w.z = cvt_pk_bf16(hv[4], hv[5]); w.w = cvt_pk_bf16(hv[6], hv[7]);
                    *(u32x4*)(SG + ((size_t)ch * 64 + j) * 512 + gq * 16 + ho0) = w;
                } }
    }
};
struct EpiGLU {
    const bf16_t* SG; bf16_t* MIX;
    struct Pre {}; __device__ __forceinline__ void prefetch(Pre&, const Unit&, int, int) const {}
    __device__ __forceinline__ void operator()(const Acc& acc, const Pre& pre, const Unit& u, int wr, int wc, int fr, int fq) const {
        const int row0 = u.pm * BM + wr * 64 + fr;
#pragma unroll
        for (int ai = 0; ai < 2; ++ai) {
            u32x4 pre[4][2];
#pragma unroll
            for (int m = 0; m < 4; ++m)
#pragma unroll
                for (int bj = 0; bj < 2; ++bj) pre[m][bj] = *(const u32x4*)(SG + (size_t)(row0 + ai * HALF + m * 16) * 512 + u.pn * BM + bj * HALF + wc * 32 + 8 * fq);
#pragma unroll
            for (int m = 0; m < 4; ++m) { const int row = row0 + ai * HALF + m * 16;
#pragma unroll
                for (int bj = 0; bj < 2; ++bj) {
                    const int c0 = u.pn * BM + bj * HALF + wc * 32 + 8 * fq;
                    const u32x4 sw = pre[m][bj];
                    const float sv[8] = {bf_lo(sw.x), bf_hi(sw.x), bf_lo(sw.y), bf_hi(sw.y), bf_lo(sw.z), bf_hi(sw.z), bf_lo(sw.w), bf_hi(sw.w)};
                    float hv[8];
#pragma unroll
                    for (int e = 0; e < 8; ++e) hv[e] = sv[e] * fast_rcp(1.0f + fast_exp2(-acc[ai][bj][m][e >> 2][e & 3] * LOG2E));
                    u32x4 w; w.x = cvt_pk_bf16(hv[0], hv[1]); w.y = cvt_pk_bf16(hv[2], hv[3]); w.z = cvt_pk_bf16(hv[4], hv[5]); w.w = cvt_pk_bf16(hv[6], hv[7]);
                    *(u32x4*)(MIX + (size_t)row * DM + 512 + c0) = w;
                } }
            MEMFENCE();
        }
    }
};
}

namespace att {
constexpr int NW = 8, QBLK = 32, KVBLK = 64;
constexpr int SHM_V = KVBLK * 128 * 2, SHM_K = KVBLK * 64 * 2;
constexpr int SLOT = SHM_V + SHM_K;
constexpr int OFF_WS = 3 * SLOT, OFF_ST = OFF_WS + NW * 64 * 4, LDS_BYTES = OFF_ST + 65536;
constexpr float THR = 8.f;
#define KSWZ(row, colB) ((row) * 128 + ((colB) ^ ((((row) >> 1) & 7) << 4)))
#define SBAR() __builtin_amdgcn_sched_barrier(0)
__device__ __forceinline__ int crow(int r, int hi) { return (r & 3) + 8 * (r >> 2) + 4 * hi; }
template <bool FIRST>
__device__ __forceinline__ void partialSM(f32x16& p0, f32x16& p1, float& m_reg, float& alpha, f32x16& negm) {
    float pmax = p0[0];
#pragma unroll
    for (int r = 1; r < 16; ++r) pmax = fmaxf(pmax, p0[r]);
#pragma unroll
    for (int r = 0; r < 16; ++r) pmax = fmaxf(pmax, p1[r]);
    { auto rr = __builtin_amdgcn_permlane32_swap(__float_as_uint(pmax), __float_as_uint(pmax), false, false); pmax = fmaxf(__uint_as_float(rr[0]), __uint_as_float(rr[1])); }
    if (!FIRST && __builtin_expect(__all(pmax <= THR), 1)) { alpha = 1.f; }
    else { const float d = FIRST ? pmax : fmaxf(pmax, 0.f); alpha = FIRST ? 1.f : fast_exp2(-d); m_reg += d;
#pragma unroll
        for (int r = 0; r < 16; ++r) { p0[r] -= d; p1[r] -= d; }
#pragma unroll
        for (int r = 0; r < 16; ++r) negm[r] = -m_reg;
        asm volatile("" : "+v"(negm)); }
#pragma unroll
    for (int r = 0; r < 16; ++r) p0[r] = fast_exp2(p0[r]);
}
__device__ __forceinline__ void finishSM(f32x16& p0, f32x16& p1, float alpha, float& l_reg, bf16x8& pa0, bf16x8& pa1, bf16x8& pa2, bf16x8& pa3) {
#pragma unroll
    for (int r = 0; r < 16; ++r) p1[r] = fast_exp2(p1[r]);
    float ps = 0;
#pragma unroll
    for (int r = 0; r < 16; ++r) ps += p0[r];
#pragma unroll
    for (int r = 0; r < 16; ++r) ps += p1[r];
    { auto rr = __builtin_amdgcn_permlane32_swap(__float_as_uint(ps), __float_as_uint(ps), false, false); ps = __uint_as_float(rr[0]) + __uint_as_float(rr[1]); }
    l_reg = l_reg * alpha + ps;
#define PK4(P, BASE, OUT) do { unsigned a0 = cvt_pk_bf16(P[BASE + 0], P[BASE + 1]), a1 = cvt_pk_bf16(P[BASE + 2], P[BASE + 3]);   \
    unsigned b0 = cvt_pk_bf16(P[BASE + 4], P[BASE + 5]), b1 = cvt_pk_bf16(P[BASE + 6], P[BASE + 7]);                              \
    auto r0 = __builtin_amdgcn_permlane32_swap(a0, b0, false, false); auto r1 = __builtin_amdgcn_permlane32_swap(a1, b1, false, false); \
    u32x4 w = {r0[0], r1[0], r0[1], r1[1]}; OUT = *reinterpret_cast<bf16x8*>(&w); } while (0)
    PK4(p0, 0, pa0); PK4(p0, 8, pa1); PK4(p1, 0, pa2); PK4(p1, 8, pa3);
#undef PK4
}
__device__ __forceinline__ void qkt(f32x16& p0, f32x16& p1, const char* Ks, const bf16x8* qr, int r32, int hi, const f32x16& negm) {
    p0 = negm; p1 = negm;
#pragma unroll
    for (int d0 = 0; d0 < 4; ++d0) { const int cb = (d0 * 16 + hi * 8) * 2;
        const bf16x8 b0 = *reinterpret_cast<const bf16x8*>(Ks + KSWZ(r32, cb));
        const bf16x8 b1 = *reinterpret_cast<const bf16x8*>(Ks + KSWZ(32 + r32, cb));
        p0 = __builtin_amdgcn_mfma_f32_32x32x16_bf16(b0, qr[d0], p0, 0, 0, 0);
        p1 = __builtin_amdgcn_mfma_f32_32x32x16_bf16(b1, qr[d0], p1, 0, 0, 0); }
}
__device__ __forceinline__ int v_st(int k, int c) { const int kk = (k & ~0xC) | ((k & 4) << 1) | ((k & 8) >> 1); return ((kk >> 3) * 4 + (c >> 5)) * 512 + ((kk & 7) * 32 + (c & 31)) * 2; }
__device__ __forceinline__ int v_rd_base(int lane) { return ((lane & 3) << 3) | (((lane >> 2) & 3) << 6) | (((lane >> 4) & 1) << 5) | (((lane >> 5) & 1) << 8); }
constexpr int v_rd_off(int d0, int ks, int half) { return d0 * 512 + ks * 4096 + half * 2048; }
template <int OFF> __device__ __forceinline__ s16x4 tr_read(int vb) { s16x4 r; asm volatile("ds_read_b64_tr_b16 %0, %1 offset:%2" : "=&v"(r) : "v"(vb), "i"(OFF) : "memory"); return r; }
#define PV_RD(X, D0) do { X[0] = tr_read<v_rd_off(D0, 0, 0)>(vb); X[1] = tr_read<v_rd_off(D0, 0, 1)>(vb); X[2] = tr_read<v_rd_off(D0, 1, 0)>(vb); X[3] = tr_read<v_rd_off(D0, 1, 1)>(vb); \
    X[4] = tr_read<v_rd_off(D0, 2, 0)>(vb); X[5] = tr_read<v_rd_off(D0, 2, 1)>(vb); X[6] = tr_read<v_rd_off(D0, 3, 0)>(vb); X[7] = tr_read<v_rd_off(D0, 3, 1)>(vb); } while (0)
#define PV_PK(L, H) (bf16x8){L[0], L[1], L[2], L[3], H[0], H[1], H[2], H[3]}
#define PV_MM(OD, X) do { OD = __builtin_amdgcn_mfma_f32_32x32x16_bf16(pa0, PV_PK(X[0], X[1]), OD, 0, 0, 0); OD = __builtin_amdgcn_mfma_f32_32x32x16_bf16(pa1, PV_PK(X[2], X[3]), OD, 0, 0, 0); \
    OD = __builtin_amdgcn_mfma_f32_32x32x16_bf16(pa2, PV_PK(X[4], X[5]), OD, 0, 0, 0); OD = __builtin_amdgcn_mfma_f32_32x32x16_bf16(pa3, PV_PK(X[6], X[7]), OD, 0, 0, 0); } while (0)
__device__ __forceinline__ void pv_d0(f32x16* o, int vb, bf16x8 pa0, bf16x8 pa1, bf16x8 pa2, bf16x8 pa3) {
    s16x4 fa[8], fb[8];
    PV_RD(fa, 0); PV_RD(fb, 1);
    asm volatile("s_waitcnt lgkmcnt(8)" ::: "memory"); SBAR();
    PV_MM(o[0], fa); SBAR();
    PV_RD(fa, 2);
    asm volatile("s_waitcnt lgkmcnt(8)" ::: "memory"); SBAR();
    PV_MM(o[1], fb); SBAR();
    PV_RD(fb, 3);
    asm volatile("s_waitcnt lgkmcnt(8)" ::: "memory"); SBAR();
    PV_MM(o[2], fa); SBAR();
    asm volatile("s_waitcnt lgkmcnt(0)" ::: "memory"); SBAR();
    PV_MM(o[3], fb);
}
#undef PV_RD
#undef PV_PK
#undef PV_MM
__device__ __forceinline__ bf16x8 ld8(const bf16_t* p) { return *reinterpret_cast<const bf16x8*>(p); }

template <int map>
__device__ __forceinline__ void attn_map(const bf16_t* __restrict__ Q12, const bf16_t* __restrict__ K12, const bf16_t* __restrict__ V, bf16_t* __restrict__ MIX,
                                         const float* __restrict__ subg, float lam, long row0, int seq, int h, int q0, char* lds, int wv) {
    const int tid = tidx(wv), wid = tid >> 6, lane = tid & 63, r32 = lane & 31, hi = lane >> 5;
    float* ws = (float*)(lds + OFF_WS) + wid * 64; float* li_l = ws; float* al_l = ws + 32;
    unsigned* stash = (unsigned*)(lds + OFF_ST);
    const int sr = tid >> 4, sc = (tid & 15) * 8, vst0 = v_st(sr, sc), vst1 = v_st(32 + sr, sc);
    const int kr = tid >> 3, kc = (tid & 7) * 8, kst = SHM_V + KSWZ(kr, kc * 2);
    const int vbase = (int)(uintptr_t)lds + v_rd_base(lane);
    const int NT = seq / KVBLK;
    const bf16_t* Vh = V + row0 * 512 + h * 128;
    {
        const bf16_t* Qw = Q12 + (row0 + q0 + wid * QBLK + r32) * 512 + map * 256 + h * 64 + hi * 8;
        const bf16_t* Kh = K12 + row0 * 512 + map * 256 + h * 64;
        bf16x8 qr[4];
#pragma unroll
        for (int d0 = 0; d0 < 4; ++d0) qr[d0] = ld8(Qw + d0 * 16);
        float m_reg = 0.f, l_reg = 0.f; f32x16 o[4] = {}; f32x16 negm = {};
        struct { bf16x8 vs0, vs1, ks; } sr_;
#define SLOAD(k0) do { sr_.vs0 = ld8(&Vh[(long)((k0) + sr) * 512 + sc]); sr_.vs1 = ld8(&Vh[(long)((k0) + 32 + sr) * 512 + sc]); sr_.ks = ld8(&Kh[(long)((k0) + kr) * 512 + kc]); } while (0)
#define SWRITE(so) do { *(bf16x8*)(lds + (so) + vst0) = sr_.vs0; *(bf16x8*)(lds + (so) + vst1) = sr_.vs1; *(bf16x8*)(lds + (so) + kst) = sr_.ks; } while (0)
#define SWAIT() asm volatile("s_waitcnt vmcnt(0)" ::: "memory")
#define RESC(a) do { if (__any((a) < 1.f)) { if (hi == 0) al_l[r32] = (a); asm volatile("s_waitcnt lgkmcnt(0)" ::: "memory"); \
    _Pragma("unroll") for (int d = 0; d < 4; ++d) _Pragma("unroll") for (int r = 0; r < 16; ++r) o[d][r] *= al_l[crow(r, hi)]; } } while (0)
#define KPTR(so) (lds + (so) + SHM_V)
#define ROT() do { const int t_ = s_prev; s_prev = s_cur; s_cur = s_nxt; s_nxt = t_; } while (0)
        f32x16 pA0, pA1, pB0, pB1; float alA, alB; bf16x8 pa0, pa1, pa2, pa3;
        { const bf16x8 t0 = ld8(&Vh[(long)(KVBLK + sr) * 512 + sc]), t1 = ld8(&Vh[(long)(KVBLK + 32 + sr) * 512 + sc]), t2 = ld8(&Kh[(long)(KVBLK + kr) * 512 + kc]);
          SLOAD(0); asm volatile("s_waitcnt vmcnt(0)" ::: "memory"); SWRITE(0);
          *(bf16x8*)(lds + SLOT + vst0) = t0; *(bf16x8*)(lds + SLOT + vst1) = t1; *(bf16x8*)(lds + SLOT + kst) = t2; }
        __syncthreads();
        qkt(pA0, pA1, KPTR(0), qr, r32, hi, negm); partialSM<true>(pA0, pA1, m_reg, alA, negm);
        int s_prev = 0, s_cur = SLOT, s_nxt = 2 * SLOT;
        for (int j = 1; j + 1 < NT; j += 2) {
            SBAR(); qkt(pB0, pB1, KPTR(s_cur), qr, r32, hi, negm);
            finishSM(pA0, pA1, alA, l_reg, pa0, pa1, pa2, pa3); SBAR();
            SLOAD((j + 1) * KVBLK); SBAR();
            pv_d0(o, vbase + s_prev, pa0, pa1, pa2, pa3); partialSM<false>(pB0, pB1, m_reg, alB, negm);
            SWAIT(); SWRITE(s_nxt);
            RESC(alB); __syncthreads(); ROT();
            SBAR(); qkt(pA0, pA1, KPTR(s_cur), qr, r32, hi, negm);
            finishSM(pB0, pB1, alB, l_reg, pa0, pa1, pa2, pa3); SBAR();
            SLOAD((j + 2) * KVBLK); SBAR();
            pv_d0(o, vbase + s_prev, pa0, pa1, pa2, pa3); partialSM<false>(pA0, pA1, m_reg, alA, negm);
            SWAIT(); SWRITE(s_nxt);
            RESC(alA); __syncthreads(); ROT();
        }
        SBAR(); qkt(pB0, pB1, KPTR(s_cur), qr, r32, hi, negm);
        finishSM(pA0, pA1, alA, l_reg, pa0, pa1, pa2, pa3); SBAR();
        pv_d0(o, vbase + s_prev, pa0, pa1, pa2, pa3); partialSM<false>(pB0, pB1, m_reg, alB, negm);
        RESC(alB);
        finishSM(pB0, pB1, alB, l_reg, pa0, pa1, pa2, pa3); SBAR();
        pv_d0(o, vbase + s_cur, pa0, pa1, pa2, pa3);
#undef KPTR
#undef ROT
#undef SLOAD
#undef SWRITE
#undef SWAIT
#undef RESC
        if (hi == 0) li_l[r32] = l_reg; asm volatile("s_waitcnt lgkmcnt(0)" ::: "memory");
        float rli[16];
#pragma unroll
        for (int r = 0; r < 16; ++r) rli[r] = fast_rcp(li_l[crow(r, hi)]);
        if (map == 0) {
#pragma unroll
            for (int d0 = 0; d0 < 4; ++d0)
#pragma unroll
                for (int r = 0; r < 16; r += 2) stash[wid * 2048 + (d0 * 8 + (r >> 1)) * 64 + lane] = cvt_pk_bf16(o[d0][r] * rli[r], o[d0][r + 1] * rli[r + 1]);
        } else {
            float ssq[16];
#pragma unroll
            for (int r = 0; r < 16; ++r) ssq[r] = 0.f;
#pragma unroll
            for (int d0 = 0; d0 < 4; ++d0)
#pragma unroll
                for (int r = 0; r < 16; r += 2) { const unsigned w = stash[wid * 2048 + (d0 * 8 + (r >> 1)) * 64 + lane];
                    const float v0 = bf_lo(w) - lam * (o[d0][r] * rli[r]), v1 = bf_hi(w) - lam * (o[d0][r + 1] * rli[r + 1]);
                    o[d0][r] = v0; o[d0][r + 1] = v1; ssq[r] += v0 * v0; ssq[r + 1] += v1 * v1; }
#pragma unroll
            for (int r = 0; r < 16; ++r) { float s = ssq[r]; s += __shfl_xor(s, 1); s += __shfl_xor(s, 2); s += __shfl_xor(s, 4); s += __shfl_xor(s, 8); s += __shfl_xor(s, 16);
                ssq[r] = rsqrtf(s * (1.0f / 128.0f) + 1e-5f) * 0.8f; }
            asm volatile("s_waitcnt lgkmcnt(0)" ::: "memory");
            bf16_t* stg = (bf16_t*)(stash + wid * 2048);
#pragma unroll
            for (int d0 = 0; d0 < 4; ++d0) { const float gn = subg[d0 * 32 + r32];
#pragma unroll
                for (int r = 0; r < 16; ++r) { const unsigned w = cvt_pk_bf16(o[d0][r] * ssq[r] * gn, 0.f); stg[crow(r, hi) * 128 + d0 * 32 + r32] = (bf16_t)(w & 0xffffu); } }
            asm volatile("s_waitcnt lgkmcnt(0)" ::: "memory");
            bf16_t* Ow = MIX + (row0 + q0 + wid * QBLK) * 1024 + h * 128;
#pragma unroll
            for (int i = 0; i < 8; ++i) { const int row = i * 4 + (lane >> 4), ch = lane & 15; const u32x4 v = *(const u32x4*)(stg + row * 128 + ch * 8); *(u32x4*)(Ow + (long)row * 1024 + ch * 8) = v; }
        }
        __syncthreads();
    }
}
__device__ __forceinline__ void attn_unit(const bf16_t* __restrict__ Q12, const bf16_t* __restrict__ K12, const bf16_t* __restrict__ V, bf16_t* __restrict__ MIX,
                                          const float* __restrict__ subg, float lam, long row0, int seq, int h, int q0, char* lds, int wv) {
    attn_map<0>(Q12, K12, V, MIX, subg, lam, row0, seq, h, q0, lds, wv);
    attn_map<1>(Q12, K12, V, MIX, subg, lam, row0, seq, h, q0, lds, wv);
}
#undef SBAR
}

struct Args { const float* in[28]; float* out; unsigned char* ws; int ph_lo, ph_hi; };
enum { I_XP = 0, I_XS, I_N1, I_G1, I_U1, I_D1, I_MIXN, I_WIN, I_LQ1, I_LK1, I_LQ2, I_LK2, I_SUBN, I_ARE, I_AIM, I_LDT, I_BRE, I_BIM, I_CRE, I_CIM, I_SSMD, I_WGLU, I_WOUT, I_N2, I_G2, I_U2, I_D2, I_FN };
constexpr int NPHASE = 13;
constexpr int FFN_CHUNKS = 1, FFN_MC = MT / FFN_CHUNKS;
#ifndef STAG_DOWN
#define STAG_DOWN 0
#endif
#ifndef STAG_OUT
#define STAG_OUT 0
#endif
constexpr int LDS_BYTES = 147456;
constexpr int NTHR = 512;

struct cplx { double re, im; };
__device__ __forceinline__ cplx cmul(cplx a, cplx b) { return {a.re * b.re - a.im * b.im, a.re * b.im + a.im * b.re}; }
__device__ __forceinline__ void sincos_rev(double r, double& s, double& c) {
    const double x = r * 6.283185307179586476925 * 0.125, x2 = x * x;
    double sp = 1.0 / 6227020800.0; sp = sp * (-x2) + 1.0 / 39916800.0; sp = sp * (-x2) + 1.0 / 362880.0; sp = sp * (-x2) + 1.0 / 5040.0; sp = sp * (-x2) + 1.0 / 120.0; sp = sp * (-x2) + 1.0 / 6.0; sp = sp * (-x2) + 1.0; sp *= x;
    double cp = 1.0 / 87178291200.0; cp = cp * (-x2) + 1.0 / 479001600.0; cp = cp * (-x2) + 1.0 / 3628800.0; cp = cp * (-x2) + 1.0 / 40320.0; cp = cp * (-x2) + 1.0 / 720.0; cp = cp * (-x2) + 1.0 / 24.0; cp = cp * (-x2) + 0.5; cp = 1.0 - cp * x2;
#pragma unroll
    for (int i = 0; i < 3; ++i) { const double s2 = 2.0 * sp * cp, c2 = 1.0 - 2.0 * sp * sp; sp = s2; cp = c2; }
    s = sp; c = cp;
}
__device__ __forceinline__ void sincos_big(double ang, double& s, double& c) { const double t = ang * 0.15915494309189533576888; sincos_rev(t - rint(t), s, c); }

__device__ __forceinline__ void phase_tables(const Args& a, unsigned char* ws, unsigned char* dob, int wv) {
    const int gt = blockIdx.x * NTHR + tidx(wv), GN = gridDim.x * NTHR;
    f32x2* LPOW = (f32x2*)(dob + DO_LPOW); f32x2* BBAR = (f32x2*)(ws + WS_BBAR); f32x2* ROPE = (f32x2*)(ws + WS_ROPE);
    const float *are = a.in[I_ARE], *aim = a.in[I_AIM], *ldt = a.in[I_LDT], *bre = a.in[I_BRE], *bim = a.in[I_BIM];
    for (int i = gt; i < 4096 * 65; i += GN) { const int s = i / 65, k = i - s * 65, gq = s >> 7, dir = (s >> 6) & 1, p = s & 63, idx = (dir * 32 + gq) * 64 + p;
        const double dt = exp((double)ldt[idx]); const double mag = exp((double)k * (double)are[idx] * dt); double sn, cs; sincos_big((double)k * (double)aim[idx] * dt, sn, cs);
        LPOW[i] = (f32x2){(float)(mag * cs), (float)(mag * sn)}; }
    for (int i = gt; i < 4096 * 16; i += GN) { const int s = i >> 4, hh = i & 15, gq = s >> 7, dir = (s >> 6) & 1, p = s & 63, idx = (dir * 32 + gq) * 64 + p;
        const double ar = are[idx], ai = aim[idx], dt = exp((double)ldt[idx]); const double mag = exp(ar * dt); double sn, cs; sincos_big(ai * dt, sn, cs);
        const cplx num = {mag * cs - 1.0, mag * sn}; const double den = ar * ar + ai * ai; const cplx coef = {(num.re * ar + num.im * ai) / den, (num.im * ar - num.re * ai) / den};
        const cplx b = {(double)bre[(size_t)idx * 16 + hh], (double)bim[(size_t)idx * 16 + hh]}; const cplx r = cmul(coef, b);
        BBAR[i] = (f32x2){(float)r.re, (float)r.im}; }
    for (int i = gt; i < 4096 * 32; i += GN) { const int pos = i >> 5, j = i & 31; const float inv = powf(10000.0f, -(float)j / 32.0f); const float ang = (float)pos * inv;
        double sn, cs; sincos_big((double)ang, sn, cs); ROPE[i] = (f32x2){(float)cs, (float)sn}; }
    if (gt == 0) { float s1 = 0.f, s2 = 0.f; for (int i = 0; i < 64; ++i) { s1 += a.in[I_LQ1][i] * a.in[I_LK1][i]; s2 += a.in[I_LQ2][i] * a.in[I_LK2][i]; }
        ((float*)(ws + WS_SCAL))[0] = expf(s1) - expf(s2) + 0.2f; }
}
__device__ __forceinline__ unsigned f2bf(float f) { unsigned u = __builtin_bit_cast(unsigned, f); return (u + 0x7fffu + ((u >> 16) & 1u)) >> 16; }
__device__ __forceinline__ unsigned pk2(float lo, float hi) { return f2bf(lo) | (f2bf(hi) << 16); }
__device__ __forceinline__ void tr_item(const float* W, int N, bf16_t* WT, int ldt, int k0, int n0, int drow0, const float* gain, LAS float* scr, int lane) {
    { const int r8 = lane >> 3, c4 = (lane & 7) * 4; f32x4 v[8];
#pragma unroll
      for (int i = 0; i < 8; ++i) v[i] = *(const f32x4*)(W + (size_t)(k0 + i * 8 + r8) * N + n0 + c4);
#pragma unroll
      for (int i = 0; i < 8; ++i) { const int kk = i * 8 + r8; const float g = gain ? gain[k0 + kk] : 1.0f; LAS float* d = scr + kk * 33 + c4;
          d[0] = v[i].x * g; d[1] = v[i].y * g; d[2] = v[i].z * g; d[3] = v[i].w * g; } }
    LDS_WAIT(); MEMFENCE();
    const int c = lane & 7;
#pragma unroll
    for (int j = 0; j < 4; ++j) { const int n = (lane >> 3) + 8 * j; const LAS float* s = scr + (8 * c) * 33 + n;
        u32x4 o; o.x = pk2(s[0 * 33], s[1 * 33]); o.y = pk2(s[2 * 33], s[3 * 33]); o.z = pk2(s[4 * 33], s[5 * 33]); o.w = pk2(s[6 * 33], s[7 * 33]);
        *(u32x4*)(WT + (size_t)(drow0 + n) * ldt + k0 + 8 * c) = o; }
    LDS_WAIT(); MEMFENCE();
}
__device__ __forceinline__ float wave_sum(float v) {
#pragma unroll
    for (int o = 1; o < 64; o <<= 1) v += __shfl_xor(v, o);
    return v;
}
__device__ __forceinline__ void phase_prep(const Args& a, unsigned char* ws, unsigned char* dob, LAS unsigned char* lds, int wv) {
    const int tid = tidx(wv), lane = tid & 63, wave = tid >> 6;
    const int gw = blockIdx.x * 8 + wave, NGW = gridDim.x * 8;
    const int gt = blockIdx.x * NTHR + tid, GN = gridDim.x * NTHR;
    LAS float* scr = (LAS float*)(lds + wave * 16384);
    constexpr int I_FF = 16 * 88, I_FD = 44 * 32, I_IN = 16 * 64, I_OUT = 16 * 32, I_GLU = 8 * 16;
    static_assert(I_FF == I_FD, "item counts");
    constexpr int NITEMS = 6 * I_FF + I_IN + I_OUT + I_GLU;
    for (int it = gw; it < NITEMS; it += NGW) {
        int r = it;
        if (r < 6 * I_FF) {
            const int blk = r / I_FF, layer = blk / 3, kind = blk % 3; r -= blk * I_FF;
            const float* gain = a.in[layer ? I_N2 : I_N1];
            if (kind < 2) { const int kb = r / 88, nb = r % 88, n0 = nb * 32; const int drow0 = 256 * (n0 >> 7) + 128 * kind + (n0 & 127);
                tr_item(a.in[(layer ? I_G2 : I_G1) + kind], DFF, (bf16_t*)(ws + (layer ? WS_W2 : WS_W1)), 1024, kb * 64, n0, drow0, gain, scr, lane); }
            else { const int kb = r / 32, nb = r % 32; tr_item(a.in[layer ? I_D2 : I_D1], 1024, (bf16_t*)(ws + (layer ? WS_W2D : WS_W1D)), DFF, kb * 64, nb * 32, nb * 32, nullptr, scr, lane); }
            continue;
        }
        r -= 6 * I_FF;
        if (r < I_IN) { const int kb = r / 64, nb = r % 64, n0 = nb * 32; int drow0 = n0;
            if (n0 < 1024) { const int L = n0 & 255; drow0 = (n0 & ~255) + ((L >> 5) & 1) * 128 + (L >> 6) * 32; }
            tr_item(a.in[I_WIN], 2048, (bf16_t*)(ws + WS_WIN), 1024, kb * 64, n0, drow0, a.in[I_MIXN], scr, lane); continue; }
        r -= I_IN;
        if (r < I_OUT) { const int kb = r / 32, nb = r % 32; tr_item(a.in[I_WOUT], 1024, (bf16_t*)(ws + WS_WOUT), 1024, kb * 64, nb * 32, nb * 32, nullptr, scr, lane); continue; }
        r -= I_OUT;
        { const int kb = r / 16, nb = r % 16; tr_item(a.in[I_WGLU], 512, (bf16_t*)(ws + WS_WGLU), 512, kb * 64, nb * 32, nb * 32, nullptr, scr, lane); }
    }
    const f32x2* LPOW = (const f32x2*)(dob + DO_LPOW); const f32x2* BBAR = (const f32x2*)(ws + WS_BBAR);
    const float *cre = a.in[I_CRE], *cim = a.in[I_CIM];
    float* KK = (float*)(dob + DO_KK);
    for (int i = gt; i < 32 * 2 * 64 * 16 * 2; i += GN) { const int ph = i & 1, rest = i >> 1, ho = rest & 15, k = (rest >> 4) & 63, dir = (rest >> 10) & 1, gq = rest >> 11;
        const int s0 = (gq * 2 + dir) * 64; const size_t cb = ((size_t)(dir * 32 + gq) * 16 + ho) * 64;
        float accv[16];
#pragma unroll
        for (int e = 0; e < 16; ++e) accv[e] = 0.f;
        for (int p = ph * 32; p < ph * 32 + 32; ++p) { const f32x2 L = LPOW[(size_t)(s0 + p) * 65 + k]; const float cr = cre[cb + p], ci = cim[cb + p];
            const float tr = cr * L.x - ci * L.y, ti = cr * L.y + ci * L.x; const f32x2* bb = BBAR + (size_t)(s0 + p) * 16;
#pragma unroll
            for (int e = 0; e < 16; ++e) { const f32x2 b = bb[e]; accv[e] += tr * b.x - ti * b.y; } }
#pragma unroll
        for (int e = 0; e < 16; ++e) accv[e] += __shfl_xor(accv[e], 1);
        if (dir == 0 && k == 0) accv[ho] += a.in[I_SSMD][gq * 16 + ho];
        float* dst = KK + (((size_t)(gq * 2 + dir) * 64 + k) * 16 + ho) * 16 + ph * 8;
        if (ph == 0) { *(f32x4*)dst = (f32x4){accv[0], accv[1], accv[2], accv[3]}; *(f32x4*)(dst + 4) = (f32x4){accv[4], accv[5], accv[6], accv[7]}; }
        else { *(f32x4*)dst = (f32x4){accv[8], accv[9], accv[10], accv[11]}; *(f32x4*)(dst + 4) = (f32x4){accv[12], accv[13], accv[14], accv[15]}; } }
    bf16_t* WSM = (bf16_t*)(dob + DO_WSM);
    for (int i = gt; i < 32 * 256 * 64 * 2; i += GN) { const int half = i & 1, ii = (i >> 1) & 63, n = (i >> 7) & 255, gq = i >> 15; const int dir = n >> 7, ri = (n >> 6) & 1, p = n & 63;
        const int s = (gq * 2 + dir) * 64 + p; const f32x2 L = LPOW[(size_t)s * 65 + (dir ? ii : 63 - ii)]; const f32x2* bb = BBAR + (size_t)s * 16 + half * 8;
        float v[8];
#pragma unroll
        for (int e = 0; e < 8; ++e) { const f32x2 b = bb[e]; v[e] = ri ? (L.x * b.y + L.y * b.x) : (L.x * b.x - L.y * b.y); }
        u32x4 w; w.x = pk2(v[0], v[1]); w.y = pk2(v[2], v[3]); w.z = pk2(v[4], v[5]); w.w = pk2(v[6], v[7]);
        *(u32x4*)(WSM + ((size_t)(gq * 256 + n)) * 1024 + ii * 16 + half * 8) = w; }
    bf16_t* BTY = (bf16_t*)(dob + DO_BTY);
    for (int i = gt; i < 32 * 1024 * 32; i += GN) { const int pb = i & 7, ri = (i >> 3) & 1, dir = (i >> 4) & 1, n = (i >> 5) & 1023, gq = i >> 15; const int j = n >> 4, ho = n & 15;
        const int s0 = (gq * 2 + dir) * 64 + pb * 8; const size_t cb = ((size_t)(dir * 32 + gq) * 16 + ho) * 64 + pb * 8; const int e = dir ? 64 - j : j + 1;
        float v[8];
#pragma unroll
        for (int q = 0; q < 8; ++q) { const f32x2 L = LPOW[(size_t)(s0 + q) * 65 + e]; const float cr = cre[cb + q], ci = cim[cb + q]; v[q] = ri ? -(cr * L.y + ci * L.x) : (cr * L.x - ci * L.y); }
        u32x4 w; w.x = pk2(v[0], v[1]); w.y = pk2(v[2], v[3]); w.z = pk2(v[4], v[5]); w.w = pk2(v[6], v[7]);
        *(u32x4*)(BTY + ((size_t)(gq * 1024 + n)) * LDU + 1024 + dir * 128 + ri * 64 + pb * 8) = w; }
    bf16_t* XB = (bf16_t*)(ws + WS_XB); float* SS = (float*)(ws + WS_SS);
    for (int m = gw; m < MT; m += 2 * NGW) {
        const int m2 = (m + NGW < MT) ? m + NGW : m;
        const float* xr0 = m < MP ? a.in[I_XP] + (size_t)m * DM : a.in[I_XS] + (size_t)(m - MP) * DM;
        const float* xr1 = m2 < MP ? a.in[I_XP] + (size_t)m2 * DM : a.in[I_XS] + (size_t)(m2 - MP) * DM;
        f32x4 v[2][4];
#pragma unroll
        for (int j = 0; j < 4; ++j) { v[0][j] = ((const f32x4*)xr0)[lane + 64 * j]; v[1][j] = ((const f32x4*)xr1)[lane + 64 * j]; }
#pragma unroll
        for (int r = 0; r < 2; ++r) { const int mm = r ? m2 : m; float s = 0.f;
#pragma unroll
            for (int j = 0; j < 4; ++j) s += (v[r][j].x * v[r][j].x + v[r][j].y * v[r][j].y) + (v[r][j].z * v[r][j].z + v[r][j].w * v[r][j].w);
            s = wave_sum(s);
            u32x2* o8 = (u32x2*)(XB + (size_t)mm * DM) + lane;
#pragma unroll
            for (int j = 0; j < 4; ++j) o8[64 * j] = (u32x2){pk2(v[r][j].x, v[r][j].y), pk2(v[r][j].z, v[r][j].w)};
            if (lane < 2) SS[(size_t)(lane + 1) * MT + mm] = 0.f;
            if (lane == 0) SS[mm] = s; }
    }
}
__device__ __forceinline__ void phase_toeplitz(unsigned char* dob, int wv) {
    const int gt = blockIdx.x * NTHR + tidx(wv), GN = gridDim.x * NTHR;
    const float* KK = (const float*)(dob + DO_KK); bf16_t* BTY = (bf16_t*)(dob + DO_BTY);
#pragma unroll 4
    for (int it = gt; it < 32 * 1024 * 128; it += GN) { const int half = it & 1, i = (it >> 1) & 63, n = (it >> 7) & 1023, gq = it >> 17; const int j = n >> 4, ho = n & 15;
        const int kf = j >= i ? j - i : 0, kb = i >= j ? i - j : 0; const float mf = j >= i ? 1.f : 0.f, mb = i >= j ? 1.f : 0.f;
        const float* sf = KK + (((size_t)(gq * 2 + 0) * 64 + kf) * 16 + ho) * 16 + half * 8; const float* sb = KK + (((size_t)(gq * 2 + 1) * 64 + kb) * 16 + ho) * 16 + half * 8;
        const f32x4 f0 = *(const f32x4*)sf, f1 = *(const f32x4*)(sf + 4), b0 = *(const f32x4*)sb, b1 = *(const f32x4*)(sb + 4);
        const f32x4 v0 = f0 * mf + b0 * mb, v1 = f1 * mf + b1 * mb;
        u32x4 w; w.x = pk2(v0.x, v0.y); w.y = pk2(v0.z, v0.w); w.z = pk2(v1.x, v1.y); w.w = pk2(v1.z, v1.w);
        *(u32x4*)(BTY + ((size_t)(gq * 1024 + n)) * LDU + i * 16 + half * 8) = w; }
}
__device__ __forceinline__ void phase_chunkscan(unsigned char* ws, unsigned char* dob, int wv) {
    const int gt = blockIdx.x * NTHR + tidx(wv), GN = gridDim.x * NTHR;
    const f32x2* LPOW = (const f32x2*)(dob + DO_LPOW); const float* S = (const float*)(ws + WS_S); bf16_t* UH = (bf16_t*)(ws + WS_UH);
    for (int it = gt; it < 32 * 40 * 128; it += GN) { const int p = it & 63, dir = (it >> 6) & 1, rest = it >> 7, bt = rest % 40, gq = rest / 40;
        const int c0 = bt < 32 ? bt * 32 : 1024 + (bt - 32) * 64, nc = bt < 32 ? 32 : 64;
        const f32x2 L = LPOW[(size_t)((gq * 2 + dir) * 64 + p) * 65 + 64];
        float hr = 0.f, hi_ = 0.f;
        for (int cb = 0; cb < nc; cb += 8) {
            float sr[8], si[8];
#pragma unroll
            for (int q = 0; q < 8; ++q) { const int cc = cb + q, c = dir ? nc - 1 - cc : cc; const size_t row = (size_t)gq * NCH + c0 + c;
                sr[q] = S[row * 256 + dir * 128 + p]; si[q] = S[row * 256 + dir * 128 + 64 + p]; }
#pragma unroll
            for (int q = 0; q < 8; ++q) { const int cc = cb + q, c = dir ? nc - 1 - cc : cc; const size_t row = (size_t)gq * NCH + c0 + c;
                bf16_t* d = UH + row * LDU + 1024 + dir * 128 + p; d[0] = (bf16_t)f2bf(hr); d[64] = (bf16_t)f2bf(hi_);
                const float nr = L.x * hr - L.y * hi_ + sr[q], ni = L.x * hi_ + L.y * hr + si[q]; hr = nr; hi_ = ni; }
        } }
}
__device__ __forceinline__ void phase_attn(const Args& a, unsigned char* ws, unsigned char* dob, char* lds, int wv) {
    const float lam = ((const float*)(ws + WS_SCAL))[0];
    const bf16_t* Q12 = (const bf16_t*)(ws + WS_Q12); const bf16_t* K12 = (const bf16_t*)(ws + WS_K12); const bf16_t* V = (const bf16_t*)(ws + WS_V); bf16_t* MIX = (bf16_t*)(dob + DO_MIX);
    for (int u = blockIdx.x; u < 1536; u += gridDim.x) {
        long row0; int seq, h, q0;
        if (u < 512) { const int i = u >> 8, cc = u & 255, x = cc & 7, j = cc >> 3; const int bh = (i * 8 + x) * 2 + (j >> 4), qb = j & 15; row0 = MP + (long)(bh >> 2) * LSM; seq = LSM; h = bh & 3; q0 = qb * 256; }
        else { const int v = u - 512, i = v >> 8, cc = v & 255, x = cc & 7, j = cc >> 3; const int bh = (i * 8 + x) * 4 + (j >> 3), qb = j & 7; row0 = (long)(bh >> 2) * LPR; seq = LPR; h = bh & 3; q0 = qb * 256; }
        att::attn_unit(Q12, K12, V, MIX, a.in[I_SUBN], lam, row0, seq, h, q0, lds, wv);
    }
}
__device__ __forceinline__ void phase_final(const Args& a, const bf16_t* XB, int wv) {
    const int tid = tidx(wv), lane = tid & 63, gw = blockIdx.x * 8 + (tid >> 6), NGW = gridDim.x * 8;
    const f32x4* gp = (const f32x4*)a.in[I_FN] + 2 * lane; f32x4 gv[2][2];
#pragma unroll
    for (int j = 0; j < 2; ++j) { gv[j][0] = gp[128 * j]; gv[j][1] = gp[128 * j + 1]; }
    for (int m = gw; m < MT; m += 2 * NGW) {
        const int m2 = m + NGW; const bool has2 = m2 < MT;
        u32x4 w[2][2];
#pragma unroll
        for (int j = 0; j < 2; ++j) { w[0][j] = ((const u32x4*)(XB + (size_t)m * DM))[lane + 64 * j]; w[1][j] = has2 ? ((const u32x4*)(XB + (size_t)m2 * DM))[lane + 64 * j] : (u32x4){0u, 0u, 0u, 0u}; }
#pragma unroll
        for (int r = 0; r < 2; ++r) { if (r == 1 && !has2) break;
            f32x4 v[2][2]; float s = 0.f;
#pragma unroll
            for (int j = 0; j < 2; ++j) { const u32x4 q = w[r][j]; v[j][0] = (f32x4){bf_lo(q.x), bf_hi(q.x), bf_lo(q.y), bf_hi(q.y)}; v[j][1] = (f32x4){bf_lo(q.z), bf_hi(q.z), bf_lo(q.w), bf_hi(q.w)};
                s += (v[j][0].x * v[j][0].x + v[j][0].y * v[j][0].y) + (v[j][0].z * v[j][0].z + v[j][0].w * v[j][0].w) + (v[j][1].x * v[j][1].x + v[j][1].y * v[j][1].y) + (v[j][1].z * v[j][1].z + v[j][1].w * v[j][1].w); }
            const float ri = rsqrtf(wave_sum(s) * (1.0f / 1024.0f) + 1e-6f);
            f32x4* o = (f32x4*)(a.out + (size_t)(r ? m2 : m) * DM) + 2 * lane;
#pragma unroll
            for (int j = 0; j < 2; ++j) { o[128 * j] = v[j][0] * ri * gv[j][0]; o[128 * j + 1] = v[j][1] * ri * gv[j][1]; } }
    }
}


#define XB_TMO      128
#define XB_XCNT(j)  (256  + 64 * (j))
#define XB_XSUB(j)  (1280 + 64 * (j))
#define XB_XGEN(j)  (2304 + 64 * (j))
#define XB_TOP      3328
#define XB_TOPGEN   3392
#define XCD_BAR_WORDS 3456
#define XB_SPIN_CAP (1u << 22)
__device__ __forceinline__ unsigned xb_ld(unsigned* p)              { return __hip_atomic_load(p, __ATOMIC_RELAXED, __HIP_MEMORY_SCOPE_AGENT); }
__device__ __forceinline__ unsigned xb_add(unsigned* p, unsigned v) { return __hip_atomic_fetch_add(p, v, __ATOMIC_RELAXED, __HIP_MEMORY_SCOPE_AGENT); }
__device__ __forceinline__ unsigned xb_xcc_id() { return (unsigned)__builtin_amdgcn_s_getreg((3 << 11) | 20) & 0xFu; }
#define XB_SPIN(cond, bar) do { unsigned _sp = 0; while (cond) { __builtin_amdgcn_s_sleep(1); \
    if ((++_sp & 255u) == 0u) { if (xb_ld(&(bar)[XB_TMO])) break; if (_sp > XB_SPIN_CAP) { atomicAdd(&(bar)[XB_TMO], 1u); break; } } } } while (0)
struct XcdBarrier { unsigned* bar; unsigned x; volatile LAS unsigned* st; bool leader; };
__device__ __forceinline__ XcdBarrier xcd_barrier_post(unsigned* bar, volatile LAS unsigned* st) {
    XcdBarrier b; b.bar = bar; b.x = xb_xcc_id(); b.st = st; b.leader = false;
    if (threadIdx.x == 0) (void)xb_add(&bar[XB_XCNT(b.x)], 1u);
    return b;
}
__device__ __forceinline__ void xcd_barrier_complete(unsigned* bar, unsigned x, unsigned& nloc, unsigned& nx) {
    const unsigned G = gridDim.x * gridDim.y * gridDim.z;
    unsigned sum, cnt, mine, sp = 0u;
    for (;;) {
        sum = 0u; cnt = 0u; mine = 0u;
#pragma unroll
        for (unsigned j = 0; j < 16; ++j) { const unsigned c = xb_ld(&bar[XB_XCNT(j)]); sum += c; cnt += (c > 0u) ? 1u : 0u; mine = (j == x) ? c : mine; }
        if (sum == G) break;
        __builtin_amdgcn_s_sleep(1);
        if ((++sp & 255u) == 0u) { if (xb_ld(&bar[XB_TMO])) break; if (sp > XB_SPIN_CAP) { atomicAdd(&bar[XB_TMO], 1u); break; } }
    }
    nloc = mine > 0u ? mine : 1u; nx = cnt > 0u ? cnt : 1u;
}
__device__ __forceinline__ void xcd_barrier(const XcdBarrier& b) {
    asm volatile("s_waitcnt vmcnt(0)" ::: "memory");
    __syncthreads();
    if (b.leader && lane_id() == 0) {
        unsigned* bar = b.bar;
        __builtin_amdgcn_s_waitcnt(0);
        unsigned nloc = b.st[0], nx = b.st[1];
        if (nloc == 0u) { xcd_barrier_complete(bar, b.x, nloc, nx); b.st[0] = nloc; b.st[1] = nx; }
        const unsigned old = xb_add(&bar[XB_XSUB(b.x)], 1u);
        const unsigned gen = old / nloc;
        if (old + 1u == (gen + 1u) * nloc) {
            __builtin_amdgcn_fence(__ATOMIC_RELEASE, "agent");
            asm volatile("s_waitcnt vmcnt(0)" ::: "memory");
            const unsigned og = xb_add(&bar[XB_TOP], 1u);
            const unsigned tg = og / nx;
            if (og + 1u == (tg + 1u) * nx) xb_add(&bar[XB_TOPGEN], 1u);
            else XB_SPIN(xb_ld(&bar[XB_TOPGEN]) == tg, bar);
            __builtin_amdgcn_fence(__ATOMIC_ACQUIRE, "agent");
            xb_add(&bar[XB_XGEN(b.x)], 1u);
            asm volatile("s_waitcnt vmcnt(0)" ::: "memory");
        } else {
            XB_SPIN(xb_ld(&bar[XB_XGEN(b.x)]) == gen, bar);
            __builtin_amdgcn_fence(__ATOMIC_ACQUIRE, "agent");
            asm volatile("s_waitcnt vmcnt(0)" ::: "memory");
        }
    }
    __syncthreads();
}

__global__ void __launch_bounds__(NTHR, 2) fwd_kernel(Args a) {
    extern __shared__ __attribute__((aligned(16))) unsigned char lds[];
    LAS unsigned char* L3 = (LAS unsigned char*)lds;
    unsigned char* ws = a.ws; unsigned char* dob = (unsigned char*)a.out;
    const int G = gridDim.x, lo = a.ph_lo, hi = a.ph_hi;
    const int wv = __builtin_amdgcn_readfirstlane((int)threadIdx.x >> 6);
    volatile LAS unsigned* bst = (volatile LAS unsigned*)(L3 + LDS_BYTES - 64);
    if (threadIdx.x < 2) bst[threadIdx.x] = 0u;
    __syncthreads();
    XcdBarrier xbar = xcd_barrier_post((unsigned*)(ws + WS_BAR), bst); xbar.leader = (wv == 0);
#define GSYNC() xcd_barrier(xbar)
#ifndef ONLY_PHASE
#define ONLY_PHASE -1
#endif
#define IN(k) ((ONLY_PHASE < 0 || ONLY_PHASE == (k)) && lo <= (k) && (k) < hi)
#if MK_MULTI
#define SEAM(k) do { } while (0)
#else
#define SEAM(k) do { if (IN(k) && IN((k) + 1)) { if (a.ph_hi > 1000) cg::this_grid().sync(); else GSYNC(); } } while (0)
#endif
    bf16_t* XB = (bf16_t*)(ws + WS_XB); bf16_t* H = (bf16_t*)(ws + WS_H); float* SS = (float*)(ws + WS_SS);
    pg8::StaticOrder S;
#define REPS(k) for (int rep_ = 0; rep_ < ((PROBE_PHASE == (k)) ? 2 : 1); ++rep_)
#define RSYNC() do { if (rep_) GSYNC(); } while (0)
    if (IN(0)) REPS(0) { RSYNC(); phase_tables(a, ws, dob, wv); } SEAM(0);
    if (IN(1)) REPS(1) { RSYNC(); phase_prep(a, ws, dob, L3, wv); __syncthreads(); } SEAM(1);
#if MK_MULTI
    if (IN(2)) REPS(2) { RSYNC();
        phase_toeplitz(dob, wv);
        pg8::Gemm g{XB, (const bf16_t*)(ws + WS_W1), MT, 2 * DFF, 1024, 1024, 1024, 0, 0}; S.init(MT, 2 * DFF, G, (int)blockIdx.x);
        pg8::EpiSwiGLU E{H, SS}; pg8::gemm_phase(L3, g, S, E, wv);
    } SEAM(2);
    if (IN(3)) REPS(3) { RSYNC();
        pg8::Gemm g{H, (const bf16_t*)(ws + WS_W1D), MT, 1024, DFF, DFF, DFF, 0, 0}; S.init(MT, 1024, G, (int)blockIdx.x);
        pg8::EpiRes<true> E{nullptr, nullptr, XB, 0.5f, nullptr, XB, SS + MT}; pg8::gemm_phase(L3, g, S, E, wv, STAG_DOWN);
    } SEAM(3);
#else
    if (IN(2)) {
        phase_toeplitz(dob, wv);
        for (int c = 0; c < FFN_CHUNKS; ++c) {
            const size_t r0 = (size_t)c * FFN_MC;
            { pg8::Gemm g{XB + r0 * DM, (const bf16_t*)(ws + WS_W1), FFN_MC, 2 * DFF, 1024, 1024, 1024, 0, 0}; S.init(FFN_MC, 2 * DFF, G, (int)blockIdx.x);
              pg8::EpiSwiGLU E{H, SS + r0}; pg8::gemm_phase(L3, g, S, E, wv); }
            GSYNC();
            { pg8::Gemm g{H, (const bf16_t*)(ws + WS_W1D), FFN_MC, 1024, DFF, LDH, DFF, 0, 0}; S.init(FFN_MC, 1024, G, (int)blockIdx.x);
              pg8::EpiRes<true> E{nullptr, nullptr, XB + r0 * DM, 0.5f, nullptr, XB + r0 * DM, SS + MT + r0}; pg8::gemm_phase(L3, g, S, E, wv, STAG_DOWN); }
            if (c + 1 < FFN_CHUNKS) GSYNC();
        }
    } SEAM(3);
#endif
    if (IN(4)) REPS(4) { RSYNC();
        pg8::Gemm g{XB, (const bf16_t*)(ws + WS_WIN), MT, 2048, 1024, 1024, 1024, 0, 0}; S.init(MT, 2048, G, (int)blockIdx.x);
        pg8::EpiProj E{SS + MT, (const f32x4*)(ws + WS_ROPE), (bf16_t*)(ws + WS_Q12), (bf16_t*)(ws + WS_K12), (bf16_t*)(ws + WS_V), (bf16_t*)(ws + WS_UH)}; pg8::gemm_phase(L3, g, S, E, wv);
    } SEAM(4);
    if (IN(5)) REPS(5) { RSYNC();
        pg8::Gemm g{(const bf16_t*)(ws + WS_UH), (const bf16_t*)(dob + DO_WSM), MG, 256, 1024, LDU, 1024, 6, 1}; S.init(MG, 256, G, (int)blockIdx.x);
        pg8::EpiS E{(float*)(ws + WS_S)}; pg8::gemm_phase(L3, g, S, E, wv);
    } SEAM(5);
    if (IN(6)) REPS(6) { RSYNC(); phase_chunkscan(ws, dob, wv); phase_attn(a, ws, dob, (char*)lds, wv); } SEAM(6);
    if (IN(7)) REPS(7) { RSYNC();
        pg8::Gemm g{(const bf16_t*)(ws + WS_UH), (const bf16_t*)(dob + DO_BTY), MG, 1024, LDU, LDU, LDU, 6, 4}; S.init(MG, 1024, G, (int)blockIdx.x);
        pg8::EpiY E{(bf16_t*)(ws + WS_Q12)}; pg8::gemm_phase(L3, g, S, E, wv);
    } SEAM(7);
    if (IN(8)) REPS(8) { RSYNC();
        pg8::Gemm g{(const bf16_t*)(ws + WS_Q12), (const bf16_t*)(ws + WS_WGLU), MT, 512, 512, 512, 512, 0, 0}; S.init(MT, 512, G, (int)blockIdx.x);
        pg8::EpiGLU E{(const bf16_t*)(ws + WS_Q12), (bf16_t*)(dob + DO_MIX)}; pg8::gemm_phase(L3, g, S, E, wv);
    } SEAM(8);
    if (IN(9)) REPS(9) { RSYNC();
        pg8::Gemm g{(const bf16_t*)(dob + DO_MIX), (const bf16_t*)(ws + WS_WOUT), MT, 1024, 1024, 1024, 1024, 0, 0}; S.init(MT, 1024, G, (int)blockIdx.x);
        pg8::EpiRes<true> E{nullptr, nullptr, XB, 1.0f, nullptr, XB, SS + 2 * MT}; pg8::gemm_phase(L3, g, S, E, wv, STAG_OUT);
    } SEAM(9);
#if MK_MULTI
    if (IN(10)) REPS(10) { RSYNC();
        pg8::Gemm g{XB, (const bf16_t*)(ws + WS_W2), MT, 2 * DFF, 1024, 1024, 1024, 0, 0}; S.init(MT, 2 * DFF, G, (int)blockIdx.x);
        pg8::EpiSwiGLU E{H, SS + 2 * MT}; pg8::gemm_phase(L3, g, S, E, wv);
    } SEAM(10);
    if (IN(11)) REPS(11) { RSYNC();
        pg8::Gemm g{H, (const bf16_t*)(ws + WS_W2D), MT, 1024, DFF, DFF, DFF, 0, 0}; S.init(MT, 1024, G, (int)blockIdx.x);
        pg8::EpiRes<true> E{nullptr, nullptr, XB, 0.5f, nullptr, XB, nullptr}; pg8::gemm_phase(L3, g, S, E, wv, STAG_DOWN);
    } SEAM(11);
#else
    if (IN(10)) {
        for (int c = 0; c < FFN_CHUNKS; ++c) {
            const size_t r0 = (size_t)c * FFN_MC;
            { pg8::Gemm g{XB + r0 * DM, (const bf16_t*)(ws + WS_W2), FFN_MC, 2 * DFF, 1024, 1024, 1024, 0, 0}; S.init(FFN_MC, 2 * DFF, G, (int)blockIdx.x);
              pg8::EpiSwiGLU E{H, SS + 2 * MT + r0}; pg8::gemm_phase(L3, g, S, E, wv); }
            GSYNC();
            { pg8::Gemm g{H, (const bf16_t*)(ws + WS_W2D), FFN_MC, 1024, DFF, LDH, DFF, 0, 0}; S.init(FFN_MC, 1024, G, (int)blockIdx.x);
              pg8::EpiRes<true> E{nullptr, nullptr, XB + r0 * DM, 0.5f, nullptr, XB + r0 * DM, nullptr}; pg8::gemm_phase(L3, g, S, E, wv, STAG_DOWN); }
            if (c + 1 < FFN_CHUNKS) GSYNC();
        }
    } SEAM(11);
#endif
    if (IN(12)) { phase_final(a, XB, wv); }
#undef IN
#undef SEAM
}

extern "C" void kernel_launch(void* const* d_in, const int* in_sizes, int n_in, void* d_out, int out_size, void* d_ws, size_t ws_size, hipStream_t stream) {
    static int grid = 0;
    if (grid == 0) {
        if (n_in != 28 || in_sizes[0] != MP * DM || out_size != MT * DM || ws_size < WS_END) { fprintf(stderr, "kernel_launch: unexpected shapes n_in %d in0 %d out %d ws %zu\n", n_in, n_in > 0 ? in_sizes[0] : -1, out_size, ws_size); grid = -1; return; }
        int dev = 0, cus = 0, per_cu = 0;
        hipGetDevice(&dev); hipDeviceGetAttribute(&cus, hipDeviceAttributeMultiprocessorCount, dev);
        if (hipFuncSetAttribute((const void*)fwd_kernel, hipFuncAttributeMaxDynamicSharedMemorySize, LDS_BYTES) != hipSuccess) { fprintf(stderr, "kernel_launch: hipFuncSetAttribute failed\n"); grid = -1; return; }
        if (hipOccupancyMaxActiveBlocksPerMultiprocessor(&per_cu, (const void*)fwd_kernel, NTHR, LDS_BYTES) != hipSuccess || per_cu < 1) { fprintf(stderr, "kernel_launch: occupancy query says %d\n", per_cu); per_cu = 1; }
        (void)hipGetLastError();
        grid = cus * 1;
    }
    if (grid < 0) return;
    Args a{};
    for (int i = 0; i < 28; ++i) a.in[i] = (const float*)d_in[i];
    a.out = (float*)d_out; a.ws = (unsigned char*)d_ws;
#if MK_MULTI
    for (int p = 0; p < NPHASE; ++p) { a.ph_lo = p; a.ph_hi = p + 1; hipLaunchKernelGGL(fwd_kernel, dim3(grid), dim3(NTHR), LDS_BYTES, stream, a); }
#else
    a.ph_lo = 0; a.ph_hi = NPHASE;
    if (hipMemsetAsync((char*)d_ws + WS_BAR, 0, 16384, stream) != hipSuccess) { fprintf(stderr, "kernel_launch: memset of the barrier words failed\n"); return; }
    void* args[] = {&a};
    hipError_t e = hipLaunchCooperativeKernel((const void*)fwd_kernel, dim3(grid), dim3(NTHR), args, LDS_BYTES, stream);
    if (e != hipSuccess) fprintf(stderr, "kernel_launch: cooperative launch failed: %s (grid %d)\n", hipGetErrorString(e), grid);
#endif
}
```

```cpp
#include <hip/hip_runtime.h>
#include <hip/hip_cooperative_groups.h>
#include <cstdio>
#include <cstdint>
namespace cg = cooperative_groups;

#ifndef MK_MULTI
#define MK_MULTI 0
#endif

#ifndef PROBE_PHASE
#define PROBE_PHASE -1
#endif
#define LAS __attribute__((address_space(3)))
#define GAS __attribute__((address_space(1)))
typedef unsigned short bf16_t;
typedef short bf16x8 __attribute__((ext_vector_type(8)));
typedef short s16x4 __attribute__((ext_vector_type(4)));
typedef float f32x4 __attribute__((ext_vector_type(4)));
typedef float f32x2 __attribute__((ext_vector_type(2)));
typedef float f32x16 __attribute__((ext_vector_type(16)));
typedef unsigned u32x4 __attribute__((ext_vector_type(4)));
typedef unsigned u32x2 __attribute__((ext_vector_type(2)));

constexpr int DM = 1024, MP = 65536, MT = 98304, LPR = 2048, LSM = 4096, DFF = 2816;
constexpr int NCH = MT / 64;
constexpr int MG = 32 * NCH;
constexpr int LDU = 1280;
constexpr int LDH = DFF + 64;
constexpr float C2 = 0.125f * 1.4426950408889634f;
constexpr float LOG2E = 1.4426950408889634f;

constexpr size_t MiB = (size_t)1 << 20;
constexpr size_t WS_XB = 0;
constexpr size_t WS_H = 192 * MiB;
constexpr size_t WS_Q12 = 192 * MiB;
constexpr size_t WS_K12 = 288 * MiB;
constexpr size_t WS_V = 384 * MiB;
constexpr size_t WS_UH = 480 * MiB;
constexpr size_t WS_S = 600 * MiB;
constexpr size_t WS_W1 = 732 * MiB, WS_W1D = 743 * MiB, WS_WIN = 749 * MiB, WS_WOUT = 753 * MiB, WS_WGLU = 755 * MiB, WS_W2 = 756 * MiB, WS_W2D = 767 * MiB;
constexpr size_t WS_SS = 773 * MiB;
constexpr size_t WS_ROPE = 779 * MiB;
constexpr size_t WS_BBAR = 780 * MiB;
constexpr size_t WS_SCAL = 781 * MiB;
constexpr size_t WS_BAR = 782 * MiB;
constexpr size_t WS_END = 783 * MiB;
constexpr size_t DO_MIX = 0;
constexpr size_t DO_BTY = 192 * MiB;
constexpr size_t DO_WSM = 272 * MiB;
constexpr size_t DO_LPOW = 288 * MiB;
constexpr size_t DO_KK = 292 * MiB;

#define LDS_WAIT() asm volatile("s_waitcnt lgkmcnt(0)" ::: "memory")
#define VM_WAIT() asm volatile("s_waitcnt vmcnt(0)" ::: "memory")
#define MEMFENCE() asm volatile("" ::: "memory")

__device__ __forceinline__ int tidx() { int t = threadIdx.x; asm volatile("" : "+v"(t)); return t; }
__device__ __forceinline__ unsigned cvt_pk_bf16(float lo, float hi) { unsigned r; asm volatile("v_cvt_pk_bf16_f32 %0, %1, %2" : "=v"(r) : "v"(lo), "v"(hi)); return r; }
__device__ __forceinline__ float bf_lo(unsigned w) { return __uint_as_float(w << 16); }
__device__ __forceinline__ float bf_hi(unsigned w) { return __uint_as_float(w & 0xffff0000u); }
__device__ __forceinline__ float fast_rcp(float x) { return __builtin_amdgcn_rcpf(x); }
__device__ __forceinline__ float fast_exp2(float x) { return __builtin_amdgcn_exp2f(x); }
__device__ __forceinline__ float rinv_of(const float* ss, int row) { return rsqrtf(ss[row] * (1.0f / 1024.0f) + 1e-6f); }

namespace pg8 {
constexpr int BM = 256, BK = 64, HALF = 128, HTB = HALF * BK * 2, STAGE_BYTES = 8 * HTB, NXCD = 8, WGM = 8;
__host__ __device__ __forceinline__ int lds_byte(int r, int c) { const int st = (r >> 4) * 2 + (c >> 5), rr = r & 15, cc = c & 31, ob = rr * 64 + cc * 2; return st * 1024 + (ob ^ (((ob >> 9) & 1) << 5)); }
__host__ __device__ __forceinline__ void stage_rc(int b, int& R, int& C) { const int st = b / 1024, sb = b % 1024, swz = sb ^ (((sb >> 9) & 1) << 5); R = (st >> 1) * 16 + swz / 64; C = (st & 1) * 32 + (swz % 64) / 2; }
__host__ __device__ __forceinline__ int perm32(int rho) { const int n = rho >> 4, i = rho & 15; return 8 * (i >> 2) + 4 * n + (i & 3); }
struct Unit { int pm, pn; };
struct Gemm { const bf16_t* A; const bf16_t* Bt; int M, N, K, lda, ldb, gdiv, gtiles; };
struct StaticOrder {
    int nM, nN, nwg, G, c;
    __device__ void init(int M, int N, int G_, int c_) { nM = M / BM; nN = N / BM; nwg = nM * nN; G = G_; c = c_; }
    __device__ bool next(int i, Unit& u) const {
        const long L = (long)i * G + c; if (L >= nwg) return false;
        int wgid = (int)L; { const int q = nwg / NXCD, r = nwg % NXCD, xcd = wgid % NXCD, off = wgid / NXCD; wgid = (xcd < r ? xcd * (q + 1) : r * (q + 1) + (xcd - r) * q) + off; }
        const int nig = WGM * nN, gid = wgid / nig, fm = gid * WGM, gsz = (nM - fm) < WGM ? (nM - fm) : WGM;
        u.pm = fm + ((wgid % nig) % gsz); u.pn = (wgid % nig) / gsz; return true;
    }
};
template <class Epi>
__device__ __forceinline__ void gemm_phase(LAS unsigned char* lds, const Gemm g, const StaticOrder& S, const Epi& E, int stagger_us = 0) {
    if (stagger_us) { const unsigned long long t0 = __builtin_amdgcn_s_memrealtime(), dl = (unsigned long long)(((blockIdx.x >> 3) & 3) * stagger_us * 25);
        while (__builtin_amdgcn_s_memrealtime() - t0 < dl) __builtin_amdgcn_s_sleep(8); }
    const int tid = tidx(), wid = __builtin_amdgcn_readfirstlane(tid >> 6), lane = tid & 63, wr = wid >> 2, wc = wid & 3, fr = lane & 15, fq = lane >> 4;
    const int K = g.K, nt = K / BK;
    unsigned voffA[2], voffB[2];
#pragma unroll
    for (int i = 0; i < 2; ++i) { int R, C; stage_rc(tid * 16 + i * 8192, R, C); const int Rb = (R & ~31) + perm32(R & 31);
        voffA[i] = (unsigned)(R * g.lda + C) * 2u; voffB[i] = (unsigned)(Rb * g.ldb + C) * 2u; }
    const size_t kstep = (size_t)(BK * 2);
    const size_t hstepA = (size_t)HALF * g.lda * 2, hstepB = (size_t)HALF * g.ldb * 2;
    const size_t tstepA = 2 * hstepA, tstepB = 2 * hstepB;
    const unsigned ldsw = (unsigned)wid * 1024u;
    const int aoff = lds_byte(wr * 64 + fr, fq * 8), boff = lds_byte(wc * 32 + fr, fq * 8);
#define PG8_BT(u) ((u).pn + (g.gdiv ? ((u).pm / g.gdiv) * g.gtiles : 0))
#define PG8_SA(b, h) (((b) * 2 + (h)) * HTB)
#define PG8_SB(b, h) ((4 + (b) * 2 + (h)) * HTB)
#define PG8_STAGE(bufoff, gbase, voff) do { _Pragma("unroll") for (int _i = 0; _i < 2; ++_i) \
        __builtin_amdgcn_global_load_lds((const unsigned*)((const char*)(gbase) + (voff)[_i]), (LAS unsigned*)(lds + (bufoff) + ldsw + _i * 8192), 16, 0, 0); } while (0)
#define PG8_LDA(dst, b, h) do { _Pragma("unroll") for (int m = 0; m < 4; ++m) _Pragma("unroll") for (int k = 0; k < 2; ++k) dst[m][k] = *(const LAS bf16x8*)(lds + PG8_SA(b, h) + aoff + m * 2048 + k * 1024); } while (0)
#define PG8_LDB(dst, b, h) do { _Pragma("unroll") for (int n = 0; n < 2; ++n) _Pragma("unroll") for (int k = 0; k < 2; ++k) dst[n][k] = *(const LAS bf16x8*)(lds + PG8_SB(b, h) + boff + n * 2048 + k * 1024); } while (0)
#define PG8_MMA(ai, bj, At, Bt) do { __builtin_amdgcn_s_setprio(1); _Pragma("unroll") for (int m = 0; m < 4; ++m) _Pragma("unroll") for (int n = 0; n < 2; ++n) _Pragma("unroll") for (int k = 0; k < 2; ++k) \
        acc[ai][bj][m][n] = __builtin_amdgcn_mfma_f32_16x16x32_bf16(Bt[n][k], At[m][k], acc[ai][bj][m][n], 0, 0, 0); __builtin_amdgcn_s_setprio(0); } while (0)
#define PG8_WAIT_V(n) asm volatile("s_waitcnt vmcnt(" #n ")" ::: "memory")
#define PG8_WAIT_L(n) asm volatile("s_waitcnt lgkmcnt(" #n ")" ::: "memory")
#define PG8_BAR __builtin_amdgcn_s_barrier()
#define PG8_SCHED __builtin_amdgcn_sched_barrier(0)
    Unit cur, nxt; int ui = 0;
    if (!S.next(0, cur)) return;
    f32x4 acc[2][2][4][2];
#pragma unroll
    for (int a = 0; a < 2; ++a)
#pragma unroll
        for (int b = 0; b < 2; ++b)
#pragma unroll
            for (int m = 0; m < 4; ++m)
#pragma unroll
                for (int n = 0; n < 2; ++n) acc[a][b][m][n] = (f32x4){0.f, 0.f, 0.f, 0.f};
    bf16x8 At[4][2], B0[2][2], B1[2][2];
    const char* cA = (const char*)g.A + (size_t)cur.pm * tstepA; const char* cB = (const char*)g.Bt + (size_t)PG8_BT(cur) * tstepB;
    PG8_STAGE(PG8_SB(0, 0), cB, voffB); PG8_STAGE(PG8_SB(0, 1), cB + hstepB, voffB); PG8_STAGE(PG8_SA(0, 0), cA, voffA); PG8_STAGE(PG8_SA(0, 1), cA + hstepA, voffA);
    if (wr == 1) PG8_BAR;
    PG8_WAIT_V(2); PG8_BAR;
    PG8_STAGE(PG8_SB(1, 0), cB + kstep, voffB); PG8_STAGE(PG8_SA(1, 0), cA + kstep, voffA); PG8_STAGE(PG8_SB(1, 1), cB + hstepB + kstep, voffB);
    PG8_WAIT_V(6); PG8_BAR;
    for (;;) {
        const bool has_next = S.next(ui + 1, nxt);
        const char* nA = has_next ? (const char*)g.A + (size_t)nxt.pm * tstepA : cA; const char* nB = has_next ? (const char*)g.Bt + (size_t)PG8_BT(nxt) * tstepB : cB;
        typename Epi::Pre pre; E.prefetch(pre, cur, wr, fr);
        for (int t = 0; t < nt; t += 2) {
            const bool last = (t == nt - 2);
            const char* a1 = cA + (size_t)(t + 1) * kstep;
            const char* a2 = last ? nA : cA + (size_t)(t + 2) * kstep; const char* b2 = last ? nB : cB + (size_t)(t + 2) * kstep;
            const char* a3 = a2 + kstep; const char* b3 = b2 + kstep;
            PG8_LDB(B0, 0, 0); PG8_LDB(B1, 0, 1); PG8_SCHED; PG8_LDA(At, 0, 0); PG8_STAGE(PG8_SA(1, 1), a1 + hstepA, voffA);
            PG8_WAIT_V(8); PG8_WAIT_L(0); PG8_BAR; PG8_MMA(0, 0, At, B0); PG8_MMA(0, 1, At, B1); PG8_BAR; PG8_SCHED;
            PG8_LDA(At, 0, 1); PG8_STAGE(PG8_SB(0, 0), b2, voffB); PG8_STAGE(PG8_SB(0, 1), b2 + hstepB, voffB); PG8_STAGE(PG8_SA(0, 0), a2, voffA);
            PG8_WAIT_V(8); PG8_WAIT_L(0); PG8_BAR; PG8_MMA(1, 0, At, B0); PG8_MMA(1, 1, At, B1); PG8_BAR; PG8_SCHED;
            PG8_LDB(B0, 1, 0); PG8_LDB(B1, 1, 1); PG8_SCHED; PG8_LDA(At, 1, 0); PG8_STAGE(PG8_SA(0, 1), a2 + hstepA, voffA);
            PG8_WAIT_V(8); PG8_WAIT_L(0); PG8_BAR; PG8_MMA(0, 0, At, B0); PG8_MMA(0, 1, At, B1); PG8_BAR; PG8_SCHED;
            PG8_LDA(At, 1, 1); PG8_STAGE(PG8_SB(1, 0), b3, voffB); PG8_STAGE(PG8_SB(1, 1), b3 + hstepB, voffB); PG8_STAGE(PG8_SA(1, 0), a3, voffA);
            PG8_WAIT_V(8); PG8_WAIT_L(0); PG8_BAR; PG8_MMA(1, 0, At, B0); PG8_MMA(1, 1, At, B1); PG8_BAR; PG8_SCHED;
        }
        if (wr == 0) PG8_BAR;
        E(acc, pre, cur, wr, wc, fr, fq);
        if (!has_next) break;
#pragma unroll
        for (int a = 0; a < 2; ++a)
#pragma unroll
            for (int b = 0; b < 2; ++b)
#pragma unroll
                for (int m = 0; m < 4; ++m)
#pragma unroll
                    for (int n = 0; n < 2; ++n) acc[a][b][m][n] = (f32x4){0.f, 0.f, 0.f, 0.f};
        cur = nxt; cA = nA; cB = nB; ++ui;
        if (wr == 1) PG8_BAR;
    }
    PG8_WAIT_V(0);
    PG8_BAR;
#undef PG8_BT
#undef PG8_SA
#undef PG8_SB
#undef PG8_STAGE
#undef PG8_LDA
#undef PG8_LDB
#undef PG8_MMA
#undef PG8_WAIT_V
#undef PG8_WAIT_L
#undef PG8_BAR
#undef PG8_SCHED
}

typedef f32x4 Acc[2][2][4][2];

struct EpiSwiGLU {
    bf16_t* H; const float* ss;
    struct Pre { float rv[2][4]; };
    __device__ __forceinline__ void prefetch(Pre& p, const Unit& u, int wr, int fr) const {
#pragma unroll
        for (int ai = 0; ai < 2; ++ai)
#pragma unroll
            for (int m = 0; m < 4; ++m) p.rv[ai][m] = ss[u.pm * BM + wr * 64 + fr + ai * HALF + m * 16];
    }
    __device__ __forceinline__ void operator()(const Acc& acc, const Pre& pre, const Unit& u, int wr, int wc, int fr, int fq) const {
        const int row0 = u.pm * BM + wr * 64 + fr, col0 = u.pn * 128 + wc * 32 + 8 * fq;
#pragma unroll
        for (int ai = 0; ai < 2; ++ai)
#pragma unroll
            for (int m = 0; m < 4; ++m) {
                const int row = row0 + ai * HALF + m * 16; const float var = pre.rv[ai][m] * (1.0f / 1024.0f) + 1e-6f, nl = -rsqrtf(var) * LOG2E;
                float hv[8];
#pragma unroll
                for (int n = 0; n < 2; ++n)
#pragma unroll
                    for (int j = 0; j < 4; ++j) { const float gacc = acc[ai][0][m][n][j], uacc = acc[ai][1][m][n][j]; const float e = fast_exp2(gacc * nl);
                        hv[n * 4 + j] = (gacc * uacc) * fast_rcp(fmaf(e, var, var)); }
                u32x4 w; w.x = cvt_pk_bf16(hv[0], hv[1]); w.y = cvt_pk_bf16(hv[2], hv[3]); w.z = cvt_pk_bf16(hv[4], hv[5]); w.w = cvt_pk_bf16(hv[6], hv[7]);
                *(u32x4*)(H + (size_t)row * LDH + col0) = w;
            }
    }
};
template <bool B16> struct EpiRes {
    const float* baseP; const float* baseS; const bf16_t* base16; float alpha; float* out32; bf16_t* out16; float* ss;
    struct Pre {}; __device__ __forceinline__ void prefetch(Pre&, const Unit&, int, int) const {}
    __device__ __forceinline__ void operator()(const Acc& acc, const Pre& pre, const Unit& u, int wr, int wc, int fr, int fq) const {
        const int row0 = u.pm * BM + wr * 64 + fr;
        const GAS float* b32 = (u.pm < MP / BM) ? (const GAS float*)baseP : (const GAS float*)baseS - (size_t)MP * DM;
#pragma unroll
        for (int ai = 0; ai < 2; ++ai) {
            u32x4 p16[4][2]; f32x4 p32[4][2][2];
#pragma unroll
            for (int m = 0; m < 4; ++m)
#pragma unroll
                for (int bj = 0; bj < 2; ++bj) { const size_t off = (size_t)(row0 + ai * HALF + m * 16) * DM + u.pn * BM + bj * HALF + wc * 32 + 8 * fq;
                    if (B16) p16[m][bj] = *(const u32x4*)(base16 + off); else { p32[m][bj][0] = *(const GAS f32x4*)(b32 + off); p32[m][bj][1] = *(const GAS f32x4*)(b32 + off + 4); } }
#pragma unroll
            for (int m = 0; m < 4; ++m) {
                const int row = row0 + ai * HALF + m * 16; float sq = 0.f;
#pragma unroll
                for (int bj = 0; bj < 2; ++bj) {
                    const size_t off = (size_t)row * DM + u.pn * BM + bj * HALF + wc * 32 + 8 * fq;
                    f32x4 b0, b1;
                    if (B16) { const u32x4 w = p16[m][bj]; b0 = (f32x4){bf_lo(w.x), bf_hi(w.x), bf_lo(w.y), bf_hi(w.y)}; b1 = (f32x4){bf_lo(w.z), bf_hi(w.z), bf_lo(w.w), bf_hi(w.w)}; }
                    else { b0 = p32[m][bj][0]; b1 = p32[m][bj][1]; }
                    const f32x4 v0 = b0 + acc[ai][bj][m][0] * alpha, v1 = b1 + acc[ai][bj][m][1] * alpha;
                    sq += (v0.x * v0.x + v0.y * v0.y) + (v0.z * v0.z + v0.w * v0.w) + (v1.x * v1.x + v1.y * v1.y) + (v1.z * v1.z + v1.w * v1.w);
                    if (out32) { *(f32x4*)(out32 + off) = v0; *(f32x4*)(out32 + off + 4) = v1; }
                    if (out16) { u32x4 w; w.x = cvt_pk_bf16(v0.x, v0.y); w.y = cvt_pk_bf16(v0.z, v0.w); w.z = cvt_pk_bf16(v1.x, v1.y); w.w = cvt_pk_bf16(v1.z, v1.w); *(u32x4*)(out16 + off) = w; }
                }
                if (ss) { sq += __shfl_xor(sq, 16); sq += __shfl_xor(sq, 32); if (fq == 0) __hip_atomic_fetch_add(ss + row, sq, __ATOMIC_RELAXED, __HIP_MEMORY_SCOPE_AGENT); }
            }
            MEMFENCE();
        }
    }
};
struct EpiProj {
    const float* ss; const f32x4* rope; bf16_t *Q12, *K12, *V, *UH;
    struct Pre { float rv[2][4]; };
    __device__ __forceinline__ void prefetch(Pre& p, const Unit& u, int wr, int fr) const {
#pragma unroll
        for (int ai = 0; ai < 2; ++ai)
#pragma unroll
            for (int m = 0; m < 4; ++m) p.rv[ai][m] = ss[u.pm * BM + wr * 64 + fr + ai * HALF + m * 16];
    }
    __device__ __forceinline__ void operator()(const Acc& acc, const Pre& pre, const Unit& u, int wr, int wc, int fr, int fq) const {
        const int row0 = u.pm * BM + wr * 64 + fr; const int pn = u.pn;
#pragma unroll
        for (int am = 0; am < 4; ++am) {
            const int ai = am >> 1;
            f32x4 rp[2][4];
            if (pn < 4) {
#pragma unroll
                for (int mm = 0; mm < 2; ++mm) { const int m = (am & 1) * 2 + mm; const int row = row0 + ai * HALF + m * 16; const int pos = row < MP ? (row & (LPR - 1)) : ((row - MP) & (LSM - 1));
                    const f32x4* p = rope + (size_t)pos * 16 + 4 * fq;
#pragma unroll
                    for (int q = 0; q < 4; ++q) rp[mm][q] = p[q]; }
            }
#pragma unroll
            for (int mm = 0; mm < 2; ++mm) {
                const int m = (am & 1) * 2 + mm;
                const int row = row0 + ai * HALF + m * 16; const float ri = rsqrtf(pre.rv[ai][m] * (1.0f / 1024.0f) + 1e-6f);
                if (pn < 4) {
                    const float sc = (pn < 2 ? C2 : 1.0f) * ri;
                    float o1[8], o2[8];
#pragma unroll
                    for (int q = 0; q < 4; ++q) { const f32x4 cs = rp[mm][q];
                        { const int e = 2 * q; const float x1 = acc[ai][0][m][e >> 2][e & 3] * sc, x2 = acc[ai][1][m][e >> 2][e & 3] * sc; o1[e] = x1 * cs.x - x2 * cs.y; o2[e] = x2 * cs.x + x1 * cs.y; }
                        { const int e = 2 * q + 1; const float x1 = acc[ai][0][m][e >> 2][e & 3] * sc, x2 = acc[ai][1][m][e >> 2][e & 3] * sc; o1[e] = x1 * cs.z - x2 * cs.w; o2[e] = x2 * cs.z + x1 * cs.w; } }
                    bf16_t* dst = (pn < 2 ? Q12 : K12) + (size_t)row * 512 + (pn & 1) * 256 + wc * 64 + 8 * fq;
                    u32x4 w; w.x = cvt_pk_bf16(o1[0], o1[1]); w.y = cvt_pk_bf16(o1[2], o1[3]); w.z = cvt_pk_bf16(o1[4], o1[5]); w.w = cvt_pk_bf16(o1[6], o1[7]); *(u32x4*)dst = w;
                    w.x = cvt_pk_bf16(o2[0], o2[1]); w.y = cvt_pk_bf16(o2[2], o2[3]); w.z = cvt_pk_bf16(o2[4], o2[5]); w.w = cvt_pk_bf16(o2[6], o2[7]); *(u32x4*)(dst + 32) = w;
                } else {
#pragma unroll
                    for (int bj = 0; bj < 2; ++bj) {
                        const f32x4 v0 = acc[ai][bj][m][0] * ri, v1 = acc[ai][bj][m][1] * ri;
                        u32x4 w; w.x = cvt_pk_bf16(v0.x, v0.y); w.y = cvt_pk_bf16(v0.z, v0.w); w.z = cvt_pk_bf16(v1.x, v1.y); w.w = cvt_pk_bf16(v1.z, v1.w);
                        const int c0 = (pn & 1) * 256 + bj * HALF + wc * 32 + 8 * fq;
                        if (pn < 6) *(u32x4*)(V + (size_t)row * 512 + c0) = w;
                        else { const int gq = c0 >> 4, hi0 = c0 & 15; *(u32x4*)(UH + ((size_t)gq * NCH + (row >> 6)) * LDU + (row & 63) * 16 + hi0) = w; }
                    }
                }
            }
            MEMFENCE();
        }
    }
};
struct EpiS {
    float* S;
    struct Pre {}; __device__ __forceinline__ void prefetch(Pre&, const Unit&, int, int) const {}
    __device__ __forceinline__ void operator()(const Acc& acc, const Pre& pre, const Unit& u, int wr, int wc, int fr, int fq) const {
        const int row0 = u.pm * BM + wr * 64 + fr;
#pragma unroll
        for (int ai = 0; ai < 2; ++ai)
#pragma unroll
            for (int m = 0; m < 4; ++m) { const int row = row0 + ai * HALF + m * 16;
#pragma unroll
                for (int bj = 0; bj < 2; ++bj) { float* p = S + (size_t)row * 256 + bj * HALF + wc * 32 + 8 * fq; *(f32x4*)p = acc[ai][bj][m][0]; *(f32x4*)(p + 4) = acc[ai][bj][m][1]; } }
    }
};
struct EpiY {
    bf16_t* SG;
    struct Pre {}; __device__ __forceinline__ void prefetch(Pre&, const Unit&, int, int) const {}
    __device__ __forceinline__ void operator()(const Acc& acc, const Pre& pre, const Unit& u, int wr, int wc, int fr, int fq) const {
        const int row0 = u.pm * BM + wr * 64 + fr;
#pragma unroll
        for (int ai = 0; ai < 2; ++ai)
#pragma unroll
            for (int m = 0; m < 4; ++m) { const int row = row0 + ai * HALF + m * 16; const int gq = row / NCH, ch = row - gq * NCH;
#pragma unroll
                for (int bj = 0; bj < 2; ++bj) {
                    const int c0 = u.pn * BM + bj * HALF + wc * 32 + 8 * fq, j = c0 >> 4, ho0 = c0 & 15;
                    float hv[8];
#pragma unroll
                    for (int e = 0; e < 8; ++e) { const float y = acc[ai][bj][m][e >> 2][e & 3]; const float z = 1.5957691216057308f * (y + 0.044715f * y * y * y);
                        hv[e] = y * fast_rcp(1.0f + fast_exp2(-z * LOG2E)); }
                    u32x4 w; w.x = cvt_pk_bf16(hv[0], hv[1]); w.y = cvt_pk_bf16(hv[2], hv[3]); w.z = cvt_pk_bf16(hv[4], hv[5]); w.w = cvt_pk_bf16(hv[6], hv[7]);
                    *(u32x4*)(SG + ((size_t)ch * 64 + j) * 512 + gq * 16 + ho0) = w;
                } }
    }
};
struct EpiGLU {
    const bf16_t* SG; bf16_t* MIX;
    struct Pre {}; __device__ __forceinline__ void prefetch(Pre&, const Unit&, int, int) const {}
    __device__ __forceinline__ void operator()(const Acc& acc, const Pre& pre, const Unit& u, int wr, int wc, int fr, int fq) const {
        const int row0 = u.pm * BM + wr * 64 + fr;
#pragma unroll
        for (int ai = 0; ai < 2; ++ai) {
            u32x4 pre[4][2];
#pragma unroll
            for (int m = 0; m < 4; ++m)
#pragma unroll
                for (int bj = 0; bj < 2; ++bj) pre[m][bj] = *(const u32x4*)(SG + (size_t)(row0 + ai * HALF + m * 16) * 512 + u.pn * BM + bj * HALF + wc * 32 + 8 * fq);
#pragma unroll
            for (int m = 0; m < 4; ++m) { const int row = row0 + ai * HALF + m * 16;
#pragma unroll
                for (int bj = 0; bj < 2; ++bj) {
                    const int c0 = u.pn * BM + bj * HALF + wc * 32 + 8 * fq;
                    const u32x4 sw = pre[m][bj];
                    const float sv[8] = {bf_lo(sw.x), bf_hi(sw.x), bf_lo(sw.y), bf_hi(sw.y), bf_lo(sw.z), bf_hi(sw.z), bf_lo(sw.w), bf_hi(sw.w)};
                    float hv[8];
#pragma unroll
                    for (int e = 0; e < 8; ++e) hv[e] = sv[e] * fast_rcp(1.0f + fast_exp2(-acc[ai][bj][m][e >> 2][e & 3] * LOG2E));
                    u32x4 w; w.x = cvt_pk_bf16(hv[0], hv[1]); w.y = cvt_pk_bf16(hv[2], hv[3]); w.z = cvt_pk_bf16(hv[4], hv[5]); w.w = cvt_pk_bf16(hv[6], hv[7]);
                    *(u32x4*)(MIX + (size_t)row * DM + 512 + c0) = w;
                } }
            MEMFENCE();
        }
    }
};
}

namespace att {
constexpr int NW = 8, QBLK = 32, KVBLK = 64;
constexpr int SHM_V = KVBLK * 128 * 2, SHM_K = KVBLK * 64 * 2;
constexpr int SLOT = SHM_V + SHM_K;
constexpr int OFF_WS = 3 * SLOT, OFF_ST = OFF_WS + NW * 64 * 4, LDS_BYTES = OFF_ST + 65536;
constexpr float THR = 8.f;
#define KSWZ(row, colB) ((row) * 128 + ((colB) ^ ((((row) >> 1) & 7) << 4)))
#define SBAR() __builtin_amdgcn_sched_barrier(0)
__device__ __forceinline__ int crow(int r, int hi) { return (r & 3) + 8 * (r >> 2) + 4 * hi; }
template <bool FIRST>
__device__ __forceinline__ void partialSM(f32x16& p0, f32x16& p1, float& m_reg, float& alpha, f32x16& negm) {
    float pmax = p0[0];
#pragma unroll
    for (int r = 1; r < 16; ++r) pmax = fmaxf(pmax, p0[r]);
#pragma unroll
    for (int r = 0; r < 16; ++r) pmax = fmaxf(pmax, p1[r]);
    { auto rr = __builtin_amdgcn_permlane32_swap(__float_as_uint(pmax), __float_as_uint(pmax), false, false); pmax = fmaxf(__uint_as_float(rr[0]), __uint_as_float(rr[1])); }
    if (!FIRST && __builtin_expect(__all(pmax <= THR), 1)) { alpha = 1.f; }
    else { const float d = FIRST ? pmax : fmaxf(pmax, 0.f); alpha = FIRST ? 1.f : fast_exp2(-d); m_reg += d;
#pragma unroll
        for (int r = 0; r < 16; ++r) { p0[r] -= d; p1[r] -= d; }
#pragma unroll
        for (int r = 0; r < 16; ++r) negm[r] = -m_reg;
        asm volatile("" : "+v"(negm)); }
#pragma unroll
    for (int r = 0; r < 16; ++r) p0[r] = fast_exp2(p0[r]);
}
__device__ __forceinline__ void finishSM(f32x16& p0, f32x16& p1, float alpha, float& l_reg, bf16x8& pa0, bf16x8& pa1, bf16x8& pa2, bf16x8& pa3) {
#pragma unroll
    for (int r = 0; r < 16; ++r) p1[r] = fast_exp2(p1[r]);
    float ps = 0;
#pragma unroll
    for (int r = 0; r < 16; ++r) ps += p0[r];
#pragma unroll
    for (int r = 0; r < 16; ++r) ps += p1[r];
    { auto rr = __builtin_amdgcn_permlane32_swap(__float_as_uint(ps), __float_as_uint(ps), false, false); ps = __uint_as_float(rr[0]) + __uint_as_float(rr[1]); }
    l_reg = l_reg * alpha + ps;
#define PK4(P, BASE, OUT) do { unsigned a0 = cvt_pk_bf16(P[BASE + 0], P[BASE + 1]), a1 = cvt_pk_bf16(P[BASE + 2], P[BASE + 3]);   \
    unsigned b0 = cvt_pk_bf16(P[BASE + 4], P[BASE + 5]), b1 = cvt_pk_bf16(P[BASE + 6], P[BASE + 7]);                              \
    auto r0 = __builtin_amdgcn_permlane32_swap(a0, b0, false, false); auto r1 = __builtin_amdgcn_permlane32_swap(a1, b1, false, false); \
    u32x4 w = {r0[0], r1[0], r0[1], r1[1]}; OUT = *reinterpret_cast<bf16x8*>(&w); } while (0)
    PK4(p0, 0, pa0); PK4(p0, 8, pa1); PK4(p1, 0, pa2); PK4(p1, 8, pa3);
#undef PK4
}
__device__ __forceinline__ void qkt(f32x16& p0, f32x16& p1, const char* Ks, const bf16x8* qr, int r32, int hi, const f32x16& negm) {
    p0 = negm; p1 = negm;
#pragma unroll
    for (int d0 = 0; d0 < 4; ++d0) { const int cb = (d0 * 16 + hi * 8) * 2;
        const bf16x8 b0 = *reinterpret_cast<const bf16x8*>(Ks + KSWZ(r32, cb));
        const bf16x8 b1 = *reinterpret_cast<const bf16x8*>(Ks + KSWZ(32 + r32, cb));
        p0 = __builtin_amdgcn_mfma_f32_32x32x16_bf16(b0, qr[d0], p0, 0, 0, 0);
        p1 = __builtin_amdgcn_mfma_f32_32x32x16_bf16(b1, qr[d0], p1, 0, 0, 0); }
}
__device__ __forceinline__ int v_st(int k, int c) { const int kk = (k & ~0xC) | ((k & 4) << 1) | ((k & 8) >> 1); return ((kk >> 3) * 4 + (c >> 5)) * 512 + ((kk & 7) * 32 + (c & 31)) * 2; }
__device__ __forceinline__ int v_rd_base(int lane) { return ((lane & 3) << 3) | (((lane >> 2) & 3) << 6) | (((lane >> 4) & 1) << 5) | (((lane >> 5) & 1) << 8); }
constexpr int v_rd_off(int d0, int ks, int half) { return d0 * 512 + ks * 4096 + half * 2048; }
template <int OFF> __device__ __forceinline__ s16x4 tr_read(int vb) { s16x4 r; asm volatile("ds_read_b64_tr_b16 %0, %1 offset:%2" : "=&v"(r) : "v"(vb), "i"(OFF) : "memory"); return r; }
#define PV_RD(X, D0) do { X[0] = tr_read<v_rd_off(D0, 0, 0)>(vb); X[1] = tr_read<v_rd_off(D0, 0, 1)>(vb); X[2] = tr_read<v_rd_off(D0, 1, 0)>(vb); X[3] = tr_read<v_rd_off(D0, 1, 1)>(vb); \
    X[4] = tr_read<v_rd_off(D0, 2, 0)>(vb); X[5] = tr_read<v_rd_off(D0, 2, 1)>(vb); X[6] = tr_read<v_rd_off(D0, 3, 0)>(vb); X[7] = tr_read<v_rd_off(D0, 3, 1)>(vb); } while (0)
#define PV_PK(L, H) (bf16x8){L[0], L[1], L[2], L[3], H[0], H[1], H[2], H[3]}
#define PV_MM(OD, X) do { OD = __builtin_amdgcn_mfma_f32_32x32x16_bf16(pa0, PV_PK(X[0], X[1]), OD, 0, 0, 0); OD = __builtin_amdgcn_mfma_f32_32x32x16_bf16(pa1, PV_PK(X[2], X[3]), OD, 0, 0, 0); \
    OD = __builtin_amdgcn_mfma_f32_32x32x16_bf16(pa2, PV_PK(X[4], X[5]), OD, 0, 0, 0); OD = __builtin_amdgcn_mfma_f32_32x32x16_bf16(pa3, PV_PK(X[6], X[7]), OD, 0, 0, 0); } while (0)
__device__ __forceinline__ void pv_d0(f32x16* o, int vb, bf16x8 pa0, bf16x8 pa1, bf16x8 pa2, bf16x8 pa3) {
    s16x4 fa[8], fb[8];
    PV_RD(fa, 0); PV_RD(fb, 1);
    asm volatile("s_waitcnt lgkmcnt(8)" ::: "memory"); SBAR();
    PV_MM(o[0], fa); SBAR();
    PV_RD(fa, 2);
    asm volatile("s_waitcnt lgkmcnt(8)" ::: "memory"); SBAR();
    PV_MM(o[1], fb); SBAR();
    PV_RD(fb, 3);
    asm volatile("s_waitcnt lgkmcnt(8)" ::: "memory"); SBAR();
    PV_MM(o[2], fa); SBAR();
    asm volatile("s_waitcnt lgkmcnt(0)" ::: "memory"); SBAR();
    PV_MM(o[3], fb);
}
#undef PV_RD
#undef PV_PK
#undef PV_MM
__device__ __forceinline__ bf16x8 ld8(const bf16_t* p) { return *reinterpret_cast<const bf16x8*>(p); }

template <int map>
__device__ __forceinline__ void attn_map(const bf16_t* __restrict__ Q12, const bf16_t* __restrict__ K12, const bf16_t* __restrict__ V, bf16_t* __restrict__ MIX,
                                         const float* __restrict__ subg, float lam, long row0, int seq, int h, int q0, char* lds) {
    const int tid = tidx(), wid = tid >> 6, lane = tid & 63, r32 = lane & 31, hi = lane >> 5;
    float* ws = (float*)(lds + OFF_WS) + wid * 64; float* li_l = ws; float* al_l = ws + 32;
    unsigned* stash = (unsigned*)(lds + OFF_ST);
    const int sr = tid >> 4, sc = (tid & 15) * 8, vst0 = v_st(sr, sc), vst1 = v_st(32 + sr, sc);
    const int kr = tid >> 3, kc = (tid & 7) * 8, kst = SHM_V + KSWZ(kr, kc * 2);
    const int vbase = (int)(uintptr_t)lds + v_rd_base(lane);
    const int NT = seq / KVBLK;
    const bf16_t* Vh = V + row0 * 512 + h * 128;
    {
        const bf16_t* Qw = Q12 + (row0 + q0 + wid * QBLK + r32) * 512 + map * 256 + h * 64 + hi * 8;
        const bf16_t* Kh = K12 + row0 * 512 + map * 256 + h * 64;
        bf16x8 qr[4];
#pragma unroll
        for (int d0 = 0; d0 < 4; ++d0) qr[d0] = ld8(Qw + d0 * 16);
        float m_reg = 0.f, l_reg = 0.f; f32x16 o[4] = {}; f32x16 negm = {};
        struct { bf16x8 vs0, vs1, ks; } sr_;
#define SLOAD(k0) do { sr_.vs0 = ld8(&Vh[(long)((k0) + sr) * 512 + sc]); sr_.vs1 = ld8(&Vh[(long)((k0) + 32 + sr) * 512 + sc]); sr_.ks = ld8(&Kh[(long)((k0) + kr) * 512 + kc]); } while (0)
#define SWRITE(so) do { *(bf16x8*)(lds + (so) + vst0) = sr_.vs0; *(bf16x8*)(lds + (so) + vst1) = sr_.vs1; *(bf16x8*)(lds + (so) + kst) = sr_.ks; } while (0)
#define SWAIT() asm volatile("s_waitcnt vmcnt(0)" ::: "memory")
#define RESC(a) do { if (__any((a) < 1.f)) { if (hi == 0) al_l[r32] = (a); asm volatile("s_waitcnt lgkmcnt(0)" ::: "memory"); \
    _Pragma("unroll") for (int d = 0; d < 4; ++d) _Pragma("unroll") for (int r = 0; r < 16; ++r) o[d][r] *= al_l[crow(r, hi)]; } } while (0)
#define KPTR(so) (lds + (so) + SHM_V)
#define ROT() do { const int t_ = s_prev; s_prev = s_cur; s_cur = s_nxt; s_nxt = t_; } while (0)
        f32x16 pA0, pA1, pB0, pB1; float alA, alB; bf16x8 pa0, pa1, pa2, pa3;
        SLOAD(0); asm volatile("s_waitcnt vmcnt(0)" ::: "memory"); SWRITE(0); __syncthreads();
        qkt(pA0, pA1, KPTR(0), qr, r32, hi, negm); partialSM<true>(pA0, pA1, m_reg, alA, negm);
        SLOAD(KVBLK);
        SWAIT(); SWRITE(SLOT); __syncthreads();
        int s_prev = 0, s_cur = SLOT, s_nxt = 2 * SLOT;
        for (int j = 1; j + 1 < NT; j += 2) {
            SBAR(); qkt(pB0, pB1, KPTR(s_cur), qr, r32, hi, negm);
            finishSM(pA0, pA1, alA, l_reg, pa0, pa1, pa2, pa3); SBAR();
            SLOAD((j + 1) * KVBLK); SBAR();
            pv_d0(o, vbase + s_prev, pa0, pa1, pa2, pa3); partialSM<false>(pB0, pB1, m_reg, alB, negm);
            SWAIT(); SWRITE(s_nxt);
            RESC(alB); __syncthreads(); ROT();
            SBAR(); qkt(pA0, pA1, KPTR(s_cur), qr, r32, hi, negm);
            finishSM(pB0, pB1, alB, l_reg, pa0, pa1, pa2, pa3); SBAR();
            SLOAD((j + 2) * KVBLK); SBAR();
            pv_d0(o, vbase + s_prev, pa0, pa1, pa2, pa3); partialSM<false>(pA0, pA1, m_reg, alA, negm);
            SWAIT(); SWRITE(s_nxt);
            RESC(alA); __syncthreads(); ROT();
        }
        SBAR(); qkt(pB0, pB1, KPTR(s_cur), qr, r32, hi, negm);
        finishSM(pA0, pA1, alA, l_reg, pa0, pa1, pa2, pa3); SBAR();
        pv_d0(o, vbase + s_prev, pa0, pa1, pa2, pa3); partialSM<false>(pB0, pB1, m_reg, alB, negm);
        RESC(alB);
        finishSM(pB0, pB1, alB, l_reg, pa0, pa1, pa2, pa3); SBAR();
        pv_d0(o, vbase + s_cur, pa0, pa1, pa2, pa3);
#undef KPTR
#undef ROT
#undef SLOAD
#undef SWRITE
#undef SWAIT
#undef RESC
        if (hi == 0) li_l[r32] = l_reg; asm volatile("s_waitcnt lgkmcnt(0)" ::: "memory");
        float rli[16];
#pragma unroll
        for (int r = 0; r < 16; ++r) rli[r] = fast_rcp(li_l[crow(r, hi)]);
        if (map == 0) {
#pragma unroll
            for (int d0 = 0; d0 < 4; ++d0)
#pragma unroll
                for (int r = 0; r < 16; r += 2) stash[wid * 2048 + (d0 * 8 + (r >> 1)) * 64 + lane] = cvt_pk_bf16(o[d0][r] * rli[r], o[d0][r + 1] * rli[r + 1]);
        } else {
            float ssq[16];
#pragma unroll
            for (int r = 0; r < 16; ++r) ssq[r] = 0.f;
#pragma unroll
            for (int d0 = 0; d0 < 4; ++d0)
#pragma unroll
                for (int r = 0; r < 16; r += 2) { const unsigned w = stash[wid * 2048 + (d0 * 8 + (r >> 1)) * 64 + lane];
                    const float v0 = bf_lo(w) - lam * (o[d0][r] * rli[r]), v1 = bf_hi(w) - lam * (o[d0][r + 1] * rli[r + 1]);
                    o[d0][r] = v0; o[d0][r + 1] = v1; ssq[r] += v0 * v0; ssq[r + 1] += v1 * v1; }
#pragma unroll
            for (int r = 0; r < 16; ++r) { float s = ssq[r]; s += __shfl_xor(s, 1); s += __shfl_xor(s, 2); s += __shfl_xor(s, 4); s += __shfl_xor(s, 8); s += __shfl_xor(s, 16);
                ssq[r] = rsqrtf(s * (1.0f / 128.0f) + 1e-5f) * 0.8f; }
            asm volatile("s_waitcnt lgkmcnt(0)" ::: "memory");
            bf16_t* stg = (bf16_t*)(stash + wid * 2048);
#pragma unroll
            for (int d0 = 0; d0 < 4; ++d0) { const float gn = subg[d0 * 32 + r32];
#pragma unroll
                for (int r = 0; r < 16; ++r) { const unsigned w = cvt_pk_bf16(o[d0][r] * ssq[r] * gn, 0.f); stg[crow(r, hi) * 128 + d0 * 32 + r32] = (bf16_t)(w & 0xffffu); } }
            asm volatile("s_waitcnt lgkmcnt(0)" ::: "memory");
            bf16_t* Ow = MIX + (row0 + q0 + wid * QBLK) * 1024 + h * 128;
#pragma unroll
            for (int i = 0; i < 8; ++i) { const int row = i * 4 + (lane >> 4), ch = lane & 15; const u32x4 v = *(const u32x4*)(stg + row * 128 + ch * 8); *(u32x4*)(Ow + (long)row * 1024 + ch * 8) = v; }
        }
        __syncthreads();
    }
}
__device__ __forceinline__ void attn_unit(const bf16_t* __restrict__ Q12, const bf16_t* __restrict__ K12, const bf16_t* __restrict__ V, bf16_t* __restrict__ MIX,
                                          const float* __restrict__ subg, float lam, long row0, int seq, int h, int q0, char* lds) {
    attn_map<0>(Q12, K12, V, MIX, subg, lam, row0, seq, h, q0, lds);
    attn_map<1>(Q12, K12, V, MIX, subg, lam, row0, seq, h, q0, lds);
}
#undef SBAR
}

struct Args { const float* in[28]; float* out; unsigned char* ws; int ph_lo, ph_hi; };
enum { I_XP = 0, I_XS, I_N1, I_G1, I_U1, I_D1, I_MIXN, I_WIN, I_LQ1, I_LK1, I_LQ2, I_LK2, I_SUBN, I_ARE, I_AIM, I_LDT, I_BRE, I_BIM, I_CRE, I_CIM, I_SSMD, I_WGLU, I_WOUT, I_N2, I_G2, I_U2, I_D2, I_FN };
constexpr int NPHASE = 13;
constexpr int FFN_CHUNKS = 1, FFN_MC = MT / FFN_CHUNKS;
#ifndef STAG_DOWN
#define STAG_DOWN 0
#endif
#ifndef STAG_OUT
#define STAG_OUT 0
#endif
constexpr int LDS_BYTES = 147456;
constexpr int NTHR = 512;

struct cplx { double re, im; };
__device__ __forceinline__ cplx cmul(cplx a, cplx b) { return {a.re * b.re - a.im * b.im, a.re * b.im + a.im * b.re}; }
__device__ __forceinline__ void sincos_rev(double r, double& s, double& c) {
    const double x = r * 6.283185307179586476925 * 0.125, x2 = x * x;
    double sp = 1.0 / 6227020800.0; sp = sp * (-x2) + 1.0 / 39916800.0; sp = sp * (-x2) + 1.0 / 362880.0; sp = sp * (-x2) + 1.0 / 5040.0; sp = sp * (-x2) + 1.0 / 120.0; sp = sp * (-x2) + 1.0 / 6.0; sp = sp * (-x2) + 1.0; sp *= x;
    double cp = 1.0 / 87178291200.0; cp = cp * (-x2) + 1.0 / 479001600.0; cp = cp * (-x2) + 1.0 / 3628800.0; cp = cp * (-x2) + 1.0 / 40320.0; cp = cp * (-x2) + 1.0 / 720.0; cp = cp * (-x2) + 1.0 / 24.0; cp = cp * (-x2) + 0.5; cp = 1.0 - cp * x2;
#pragma unroll
    for (int i = 0; i < 3; ++i) { const double s2 = 2.0 * sp * cp, c2 = 1.0 - 2.0 * sp * sp; sp = s2; cp = c2; }
    s = sp; c = cp;
}
__device__ __forceinline__ void sincos_big(double ang, double& s, double& c) { const double t = ang * 0.15915494309189533576888; sincos_rev(t - rint(t), s, c); }

__device__ __forceinline__ void phase_tables(const Args& a, unsigned char* ws, unsigned char* dob) {
    const int gt = blockIdx.x * NTHR + tidx(), GN = gridDim.x * NTHR;
    f32x2* LPOW = (f32x2*)(dob + DO_LPOW); f32x2* BBAR = (f32x2*)(ws + WS_BBAR); f32x2* ROPE = (f32x2*)(ws + WS_ROPE);
    const float *are = a.in[I_ARE], *aim = a.in[I_AIM], *ldt = a.in[I_LDT], *bre = a.in[I_BRE], *bim = a.in[I_BIM];
    for (int i = gt; i < 4096 * 65; i += GN) { const int s = i / 65, k = i - s * 65, gq = s >> 7, dir = (s >> 6) & 1, p = s & 63, idx = (dir * 32 + gq) * 64 + p;
        const double dt = exp((double)ldt[idx]); const double mag = exp((double)k * (double)are[idx] * dt); double sn, cs; sincos_big((double)k * (double)aim[idx] * dt, sn, cs);
        LPOW[i] = (f32x2){(float)(mag * cs), (float)(mag * sn)}; }
    for (int i = gt; i < 4096 * 16; i += GN) { const int s = i >> 4, hh = i & 15, gq = s >> 7, dir = (s >> 6) & 1, p = s & 63, idx = (dir * 32 + gq) * 64 + p;
        const double ar = are[idx], ai = aim[idx], dt = exp((double)ldt[idx]); const double mag = exp(ar * dt); double sn, cs; sincos_big(ai * dt, sn, cs);
        const cplx num = {mag * cs - 1.0, mag * sn}; const double den = ar * ar + ai * ai; const cplx coef = {(num.re * ar + num.im * ai) / den, (num.im * ar - num.re * ai) / den};
        const cplx b = {(double)bre[(size_t)idx * 16 + hh], (double)bim[(size_t)idx * 16 + hh]}; const cplx r = cmul(coef, b);
        BBAR[i] = (f32x2){(float)r.re, (float)r.im}; }
    for (int i = gt; i < 4096 * 32; i += GN) { const int pos = i >> 5, j = i & 31; const float inv = powf(10000.0f, -(float)j / 32.0f); const float ang = (float)pos * inv;
        double sn, cs; sincos_big((double)ang, sn, cs); ROPE[i] = (f32x2){(float)cs, (float)sn}; }
    if (gt == 0) { float s1 = 0.f, s2 = 0.f; for (int i = 0; i < 64; ++i) { s1 += a.in[I_LQ1][i] * a.in[I_LK1][i]; s2 += a.in[I_LQ2][i] * a.in[I_LK2][i]; }
        ((float*)(ws + WS_SCAL))[0] = expf(s1) - expf(s2) + 0.2f; }
}
__device__ __forceinline__ unsigned f2bf(float f) { unsigned u = __builtin_bit_cast(unsigned, f); return (u + 0x7fffu + ((u >> 16) & 1u)) >> 16; }
__device__ __forceinline__ unsigned pk2(float lo, float hi) { return f2bf(lo) | (f2bf(hi) << 16); }
__device__ __forceinline__ void tr_item(const float* W, int N, bf16_t* WT, int ldt, int k0, int n0, int drow0, const float* gain, LAS float* scr, int lane) {
    { const int r8 = lane >> 3, c4 = (lane & 7) * 4; f32x4 v[8];
#pragma unroll
      for (int i = 0; i < 8; ++i) v[i] = *(const f32x4*)(W + (size_t)(k0 + i * 8 + r8) * N + n0 + c4);
#pragma unroll
      for (int i = 0; i < 8; ++i) { const int kk = i * 8 + r8; const float g = gain ? gain[k0 + kk] : 1.0f; LAS float* d = scr + kk * 33 + c4;
          d[0] = v[i].x * g; d[1] = v[i].y * g; d[2] = v[i].z * g; d[3] = v[i].w * g; } }
    LDS_WAIT(); MEMFENCE();
    const int c = lane & 7;
#pragma unroll
    for (int j = 0; j < 4; ++j) { const int n = (lane >> 3) + 8 * j; const LAS float* s = scr + (8 * c) * 33 + n;
        u32x4 o; o.x = pk2(s[0 * 33], s[1 * 33]); o.y = pk2(s[2 * 33], s[3 * 33]); o.z = pk2(s[4 * 33], s[5 * 33]); o.w = pk2(s[6 * 33], s[7 * 33]);
        *(u32x4*)(WT + (size_t)(drow0 + n) * ldt + k0 + 8 * c) = o; }
    LDS_WAIT(); MEMFENCE();
}
__device__ __forceinline__ float wave_sum(float v) {
#pragma unroll
    for (int o = 1; o < 64; o <<= 1) v += __shfl_xor(v, o);
    return v;
}
__device__ __forceinline__ void phase_prep(const Args& a, unsigned char* ws, unsigned char* dob, LAS unsigned char* lds) {
    const int tid = tidx(), lane = tid & 63, wave = tid >> 6;
    const int gw = blockIdx.x * 8 + wave, NGW = gridDim.x * 8;
    const int gt = blockIdx.x * NTHR + tid, GN = gridDim.x * NTHR;
    LAS float* scr = (LAS float*)(lds + wave * 16384);
    constexpr int I_FF = 16 * 88, I_FD = 44 * 32, I_IN = 16 * 64, I_OUT = 16 * 32, I_GLU = 8 * 16;
    static_assert(I_FF == I_FD, "item counts");
    constexpr int NITEMS = 6 * I_FF + I_IN + I_OUT + I_GLU;
    for (int it = gw; it < NITEMS; it += NGW) {
        int r = it;
        if (r < 6 * I_FF) {
            const int blk = r / I_FF, layer = blk / 3, kind = blk % 3; r -= blk * I_FF;
            const float* gain = a.in[layer ? I_N2 : I_N1];
            if (kind < 2) { const int kb = r / 88, nb = r % 88, n0 = nb * 32; const int drow0 = 256 * (n0 >> 7) + 128 * kind + (n0 & 127);
                tr_item(a.in[(layer ? I_G2 : I_G1) + kind], DFF, (bf16_t*)(ws + (layer ? WS_W2 : WS_W1)), 1024, kb * 64, n0, drow0, gain, scr, lane); }
            else { const int kb = r / 32, nb = r % 32; tr_item(a.in[layer ? I_D2 : I_D1], 1024, (bf16_t*)(ws + (layer ? WS_W2D : WS_W1D)), DFF, kb * 64, nb * 32, nb * 32, nullptr, scr, lane); }
            continue;
        }
        r -= 6 * I_FF;
        if (r < I_IN) { const int kb = r / 64, nb = r % 64, n0 = nb * 32; int drow0 = n0;
            if (n0 < 1024) { const int L = n0 & 255; drow0 = (n0 & ~255) + ((L >> 5) & 1) * 128 + (L >> 6) * 32; }
            tr_item(a.in[I_WIN], 2048, (bf16_t*)(ws + WS_WIN), 1024, kb * 64, n0, drow0, a.in[I_MIXN], scr, lane); continue; }
        r -= I_IN;
        if (r < I_OUT) { const int kb = r / 32, nb = r % 32; tr_item(a.in[I_WOUT], 1024, (bf16_t*)(ws + WS_WOUT), 1024, kb * 64, nb * 32, nb * 32, nullptr, scr, lane); continue; }
        r -= I_OUT;
        { const int kb = r / 16, nb = r % 16; tr_item(a.in[I_WGLU], 512, (bf16_t*)(ws + WS_WGLU), 512, kb * 64, nb * 32, nb * 32, nullptr, scr, lane); }
    }
    const f32x2* LPOW = (const f32x2*)(dob + DO_LPOW); const f32x2* BBAR = (const f32x2*)(ws + WS_BBAR);
    const float *cre = a.in[I_CRE], *cim = a.in[I_CIM];
    float* KK = (float*)(dob + DO_KK);
    for (int i = gt; i < 32 * 2 * 64 * 16 * 2; i += GN) { const int ph = i & 1, rest = i >> 1, ho = rest & 15, k = (rest >> 4) & 63, dir = (rest >> 10) & 1, gq = rest >> 11;
        const int s0 = (gq * 2 + dir) * 64; const size_t cb = ((size_t)(dir * 32 + gq) * 16 + ho) * 64;
        float accv[16];
#pragma unroll
        for (int e = 0; e < 16; ++e) accv[e] = 0.f;
#pragma unroll 8
        for (int p = ph * 32; p < ph * 32 + 32; ++p) { const f32x2 L = LPOW[(size_t)(s0 + p) * 65 + k]; const float cr = cre[cb + p], ci = cim[cb + p];
            const float tr = cr * L.x - ci * L.y, ti = cr * L.y + ci * L.x; const f32x2* bb = BBAR + (size_t)(s0 + p) * 16;
#pragma unroll
            for (int e = 0; e < 16; ++e) { const f32x2 b = bb[e]; accv[e] += tr * b.x - ti * b.y; } }
#pragma unroll
        for (int e = 0; e < 16; ++e) accv[e] += __shfl_xor(accv[e], 1);
        if (dir == 0 && k == 0) accv[ho] += a.in[I_SSMD][gq * 16 + ho];
        float* dst = KK + (((size_t)(gq * 2 + dir) * 64 + k) * 16 + ho) * 16 + ph * 8;
        if (ph == 0) { *(f32x4*)dst = (f32x4){accv[0], accv[1], accv[2], accv[3]}; *(f32x4*)(dst + 4) = (f32x4){accv[4], accv[5], accv[6], accv[7]}; }
        else { *(f32x4*)dst = (f32x4){accv[8], accv[9], accv[10], accv[11]}; *(f32x4*)(dst + 4) = (f32x4){accv[12], accv[13], accv[14], accv[15]}; } }
    bf16_t* WSM = (bf16_t*)(dob + DO_WSM);
    for (int i = gt; i < 32 * 256 * 64 * 2; i += GN) { const int half = i & 1, ii = (i >> 1) & 63, n = (i >> 7) & 255, gq = i >> 15; const int dir = n >> 7, ri = (n >> 6) & 1, p = n & 63;
        const int s = (gq * 2 + dir) * 64 + p; const f32x2 L = LPOW[(size_t)s * 65 + (dir ? ii : 63 - ii)]; const f32x2* bb = BBAR + (size_t)s * 16 + half * 8;
        float v[8];
#pragma unroll
        for (int e = 0; e < 8; ++e) { const f32x2 b = bb[e]; v[e] = ri ? (L.x * b.y + L.y * b.x) : (L.x * b.x - L.y * b.y); }
        u32x4 w; w.x = pk2(v[0], v[1]); w.y = pk2(v[2], v[3]); w.z = pk2(v[4], v[5]); w.w = pk2(v[6], v[7]);
        *(u32x4*)(WSM + ((size_t)(gq * 256 + n)) * 1024 + ii * 16 + half * 8) = w; }
    bf16_t* BTY = (bf16_t*)(dob + DO_BTY);
    for (int i = gt; i < 32 * 1024 * 32; i += GN) { const int pb = i & 7, ri = (i >> 3) & 1, dir = (i >> 4) & 1, n = (i >> 5) & 1023, gq = i >> 15; const int j = n >> 4, ho = n & 15;
        const int s0 = (gq * 2 + dir) * 64 + pb * 8; const size_t cb = ((size_t)(dir * 32 + gq) * 16 + ho) * 64 + pb * 8; const int e = dir ? 64 - j : j + 1;
        float v[8];
#pragma unroll
        for (int q = 0; q < 8; ++q) { const f32x2 L = LPOW[(size_t)(s0 + q) * 65 + e]; const float cr = cre[cb + q], ci = cim[cb + q]; v[q] = ri ? -(cr * L.y + ci * L.x) : (cr * L.x - ci * L.y); }
        u32x4 w; w.x = pk2(v[0], v[1]); w.y = pk2(v[2], v[3]); w.z = pk2(v[4], v[5]); w.w = pk2(v[6], v[7]);
        *(u32x4*)(BTY + ((size_t)(gq * 1024 + n)) * LDU + 1024 + dir * 128 + ri * 64 + pb * 8) = w; }
    bf16_t* XB = (bf16_t*)(ws + WS_XB); float* SS = (float*)(ws + WS_SS);
    for (int m = gw; m < MT; m += 2 * NGW) {
        const int m2 = (m + NGW < MT) ? m + NGW : m;
        const float* xr0 = m < MP ? a.in[I_XP] + (size_t)m * DM : a.in[I_XS] + (size_t)(m - MP) * DM;
        const float* xr1 = m2 < MP ? a.in[I_XP] + (size_t)m2 * DM : a.in[I_XS] + (size_t)(m2 - MP) * DM;
        f32x4 v[2][4];
#pragma unroll
        for (int j = 0; j < 4; ++j) { v[0][j] = ((const f32x4*)xr0)[lane + 64 * j]; v[1][j] = ((const f32x4*)xr1)[lane + 64 * j]; }
#pragma unroll
        for (int r = 0; r < 2; ++r) { const int mm = r ? m2 : m; float s = 0.f;
#pragma unroll
            for (int j = 0; j < 4; ++j) s += (v[r][j].x * v[r][j].x + v[r][j].y * v[r][j].y) + (v[r][j].z * v[r][j].z + v[r][j].w * v[r][j].w);
            s = wave_sum(s);
            u32x2* o8 = (u32x2*)(XB + (size_t)mm * DM) + lane;
#pragma unroll
            for (int j = 0; j < 4; ++j) o8[64 * j] = (u32x2){pk2(v[r][j].x, v[r][j].y), pk2(v[r][j].z, v[r][j].w)};
            if (lane < 2) SS[(size_t)(lane + 1) * MT + mm] = 0.f;
            if (lane == 0) SS[mm] = s; }
    }
}
__device__ __forceinline__ void phase_toeplitz(unsigned char* dob) {
    const int gt = blockIdx.x * NTHR + tidx(), GN = gridDim.x * NTHR;
    const float* KK = (const float*)(dob + DO_KK); bf16_t* BTY = (bf16_t*)(dob + DO_BTY);
#pragma unroll 4
    for (int it = gt; it < 32 * 1024 * 128; it += GN) { const int half = it & 1, i = (it >> 1) & 63, n = (it >> 7) & 1023, gq = it >> 17; const int j = n >> 4, ho = n & 15;
        const int kf = j >= i ? j - i : 0, kb = i >= j ? i - j : 0; const float mf = j >= i ? 1.f : 0.f, mb = i >= j ? 1.f : 0.f;
        const float* sf = KK + (((size_t)(gq * 2 + 0) * 64 + kf) * 16 + ho) * 16 + half * 8; const float* sb = KK + (((size_t)(gq * 2 + 1) * 64 + kb) * 16 + ho) * 16 + half * 8;
        const f32x4 f0 = *(const f32x4*)sf, f1 = *(const f32x4*)(sf + 4), b0 = *(const f32x4*)sb, b1 = *(const f32x4*)(sb + 4);
        const f32x4 v0 = f0 * mf + b0 * mb, v1 = f1 * mf + b1 * mb;
        u32x4 w; w.x = pk2(v0.x, v0.y); w.y = pk2(v0.z, v0.w); w.z = pk2(v1.x, v1.y); w.w = pk2(v1.z, v1.w);
        *(u32x4*)(BTY + ((size_t)(gq * 1024 + n)) * LDU + i * 16 + half * 8) = w; }
}
__device__ __forceinline__ void phase_chunkscan(unsigned char* ws, unsigned char* dob) {
    const int gt = blockIdx.x * NTHR + tidx(), GN = gridDim.x * NTHR;
    const f32x2* LPOW = (const f32x2*)(dob + DO_LPOW); const float* S = (const float*)(ws + WS_S); bf16_t* UH = (bf16_t*)(ws + WS_UH);
    for (int it = gt; it < 32 * 40 * 128; it += GN) { const int p = it & 63, dir = (it >> 6) & 1, rest = it >> 7, bt = rest % 40, gq = rest / 40;
        const int c0 = bt < 32 ? bt * 32 : 1024 + (bt - 32) * 64, nc = bt < 32 ? 32 : 64;
        const f32x2 L = LPOW[(size_t)((gq * 2 + dir) * 64 + p) * 65 + 64];
        float hr = 0.f, hi_ = 0.f;
        for (int cb = 0; cb < nc; cb += 8) {
            float sr[8], si[8];
#pragma unroll
            for (int q = 0; q < 8; ++q) { const int cc = cb + q, c = dir ? nc - 1 - cc : cc; const size_t row = (size_t)gq * NCH + c0 + c;
                sr[q] = S[row * 256 + dir * 128 + p]; si[q] = S[row * 256 + dir * 128 + 64 + p]; }
#pragma unroll
            for (int q = 0; q < 8; ++q) { const int cc = cb + q, c = dir ? nc - 1 - cc : cc; const size_t row = (size_t)gq * NCH + c0 + c;
                bf16_t* d = UH + row * LDU + 1024 + dir * 128 + p; d[0] = (bf16_t)f2bf(hr); d[64] = (bf16_t)f2bf(hi_);
                const float nr = L.x * hr - L.y * hi_ + sr[q], ni = L.x * hi_ + L.y * hr + si[q]; hr = nr; hi_ = ni; }
        } }
}
__device__ __forceinline__ void phase_attn(const Args& a, unsigned char* ws, unsigned char* dob, char* lds) {
    const float lam = ((const float*)(ws + WS_SCAL))[0];
    const bf16_t* Q12 = (const bf16_t*)(ws + WS_Q12); const bf16_t* K12 = (const bf16_t*)(ws + WS_K12); const bf16_t* V = (const bf16_t*)(ws + WS_V); bf16_t* MIX = (bf16_t*)(dob + DO_MIX);
    for (int u = blockIdx.x; u < 1536; u += gridDim.x) {
        long row0; int seq, h, q0;
        if (u < 512) { const int i = u >> 8, cc = u & 255, x = cc & 7, j = cc >> 3; const int bh = (i * 8 + x) * 2 + (j >> 4), qb = j & 15; row0 = MP + (long)(bh >> 2) * LSM; seq = LSM; h = bh & 3; q0 = qb * 256; }
        else { const int v = u - 512, i = v >> 8, cc = v & 255, x = cc & 7, j = cc >> 3; const int bh = (i * 8 + x) * 4 + (j >> 3), qb = j & 7; row0 = (long)(bh >> 2) * LPR; seq = LPR; h = bh & 3; q0 = qb * 256; }
        att::attn_unit(Q12, K12, V, MIX, a.in[I_SUBN], lam, row0, seq, h, q0, lds);
    }
}
__device__ __forceinline__ void phase_final(const Args& a, const bf16_t* XB) {
    const int tid = tidx(), lane = tid & 63, gw = blockIdx.x * 8 + (tid >> 6), NGW = gridDim.x * 8;
    const f32x4* gp = (const f32x4*)a.in[I_FN] + 2 * lane; f32x4 gv[2][2];
#pragma unroll
    for (int j = 0; j < 2; ++j) { gv[j][0] = gp[128 * j]; gv[j][1] = gp[128 * j + 1]; }
    for (int m = gw; m < MT; m += 2 * NGW) {
        const int m2 = m + NGW; const bool has2 = m2 < MT;
        u32x4 w[2][2];
#pragma unroll
        for (int j = 0; j < 2; ++j) { w[0][j] = ((const u32x4*)(XB + (size_t)m * DM))[lane + 64 * j]; w[1][j] = has2 ? ((const u32x4*)(XB + (size_t)m2 * DM))[lane + 64 * j] : (u32x4){0u, 0u, 0u, 0u}; }
#pragma unroll
        for (int r = 0; r < 2; ++r) { if (r == 1 && !has2) break;
            f32x4 v[2][2]; float s = 0.f;
#pragma unroll
            for (int j = 0; j < 2; ++j) { const u32x4 q = w[r][j]; v[j][0] = (f32x4){bf_lo(q.x), bf_hi(q.x), bf_lo(q.y), bf_hi(q.y)}; v[j][1] = (f32x4){bf_lo(q.z), bf_hi(q.z), bf_lo(q.w), bf_hi(q.w)};
                s += (v[j][0].x * v[j][0].x + v[j][0].y * v[j][0].y) + (v[j][0].z * v[j][0].z + v[j][0].w * v[j][0].w) + (v[j][1].x * v[j][1].x + v[j][1].y * v[j][1].y) + (v[j][1].z * v[j][1].z + v[j][1].w * v[j][1].w); }
            const float ri = rsqrtf(wave_sum(s) * (1.0f / 1024.0f) + 1e-6f);
            f32x4* o = (f32x4*)(a.out + (size_t)(r ? m2 : m) * DM) + 2 * lane;
#pragma unroll
            for (int j = 0; j < 2; ++j) { o[128 * j] = v[j][0] * ri * gv[j][0]; o[128 * j + 1] = v[j][1] * ri * gv[j][1]; } }
    }
}


#define XB_TMO      128
#define XB_XCNT(j)  (256  + 64 * (j))
#define XB_XSUB(j)  (1280 + 64 * (j))
#define XB_XGEN(j)  (2304 + 64 * (j))
#define XB_TOP      3328
#define XB_TOPGEN   3392
#define XCD_BAR_WORDS 3456
#define XB_SPIN_CAP (1u << 22)
__device__ __forceinline__ unsigned xb_ld(unsigned* p)              { return __hip_atomic_load(p, __ATOMIC_RELAXED, __HIP_MEMORY_SCOPE_AGENT); }
__device__ __forceinline__ unsigned xb_add(unsigned* p, unsigned v) { return __hip_atomic_fetch_add(p, v, __ATOMIC_RELAXED, __HIP_MEMORY_SCOPE_AGENT); }
__device__ __forceinline__ unsigned xb_xcc_id() { return (unsigned)__builtin_amdgcn_s_getreg((3 << 11) | 20) & 0xFu; }
#define XB_SPIN(cond, bar) do { unsigned _sp = 0; while (cond) { __builtin_amdgcn_s_sleep(1); \
    if ((++_sp & 255u) == 0u) { if (xb_ld(&(bar)[XB_TMO])) break; if (_sp > XB_SPIN_CAP) { atomicAdd(&(bar)[XB_TMO], 1u); break; } } } } while (0)
struct XcdBarrier { unsigned* bar; unsigned x; volatile LAS unsigned* st; };
__device__ __forceinline__ XcdBarrier xcd_barrier_post(unsigned* bar, volatile LAS unsigned* st) {
    XcdBarrier b; b.bar = bar; b.x = xb_xcc_id(); b.st = st;
    if (threadIdx.x == 0) (void)xb_add(&bar[XB_XCNT(b.x)], 1u);
    return b;
}
__device__ __forceinline__ void xcd_barrier_complete(unsigned* bar, unsigned x, unsigned& nloc, unsigned& nx) {
    const unsigned G = gridDim.x * gridDim.y * gridDim.z;
    unsigned sum, cnt, mine, sp = 0u;
    for (;;) {
        sum = 0u; cnt = 0u; mine = 0u;
#pragma unroll
        for (unsigned j = 0; j < 16; ++j) { const unsigned c = xb_ld(&bar[XB_XCNT(j)]); sum += c; cnt += (c > 0u) ? 1u : 0u; mine = (j == x) ? c : mine; }
        if (sum == G) break;
        __builtin_amdgcn_s_sleep(1);
        if ((++sp & 255u) == 0u) { if (xb_ld(&bar[XB_TMO])) break; if (sp > XB_SPIN_CAP) { atomicAdd(&bar[XB_TMO], 1u); break; } }
    }
    nloc = mine > 0u ? mine : 1u; nx = cnt > 0u ? cnt : 1u;
}
__device__ __forceinline__ void xcd_barrier(const XcdBarrier& b) {
    asm volatile("s_waitcnt vmcnt(0)" ::: "memory");
    __syncthreads();
    if (threadIdx.x == 0) {
        unsigned* bar = b.bar;
        __builtin_amdgcn_s_waitcnt(0);
        unsigned nloc = b.st[0], nx = b.st[1];
        if (nloc == 0u) { xcd_barrier_complete(bar, b.x, nloc, nx); b.st[0] = nloc; b.st[1] = nx; }
        const unsigned old = xb_add(&bar[XB_XSUB(b.x)], 1u);
        const unsigned gen = old / nloc;
        if (old + 1u == (gen + 1u) * nloc) {
            __builtin_amdgcn_fence(__ATOMIC_RELEASE, "agent");
            asm volatile("s_waitcnt vmcnt(0)" ::: "memory");
            const unsigned og = xb_add(&bar[XB_TOP], 1u);
            const unsigned tg = og / nx;
            if (og + 1u == (tg + 1u) * nx) xb_add(&bar[XB_TOPGEN], 1u);
            else XB_SPIN(xb_ld(&bar[XB_TOPGEN]) == tg, bar);
            __builtin_amdgcn_fence(__ATOMIC_ACQUIRE, "agent");
            xb_add(&bar[XB_XGEN(b.x)], 1u);
            asm volatile("s_waitcnt vmcnt(0)" ::: "memory");
        } else {
            XB_SPIN(xb_ld(&bar[XB_XGEN(b.x)]) == gen, bar);
            __builtin_amdgcn_fence(__ATOMIC_ACQUIRE, "agent");
            asm volatile("s_waitcnt vmcnt(0)" ::: "memory");
        }
    }
    __syncthreads();
}

__global__ void __launch_bounds__(NTHR, 2) fwd_kernel(Args a) {
    extern __shared__ __attribute__((aligned(16))) unsigned char lds[];
    LAS unsigned char* L3 = (LAS unsigned char*)lds;
    unsigned char* ws = a.ws; unsigned char* dob = (unsigned char*)a.out;
    const int G = gridDim.x, lo = a.ph_lo, hi = a.ph_hi;
    volatile LAS unsigned* bst = (volatile LAS unsigned*)(L3 + LDS_BYTES - 64);
    if (threadIdx.x < 2) bst[threadIdx.x] = 0u;
    __syncthreads();
    XcdBarrier xbar = xcd_barrier_post((unsigned*)(ws + WS_BAR), bst);
#define GSYNC() xcd_barrier(xbar)
#ifndef ONLY_PHASE
#define ONLY_PHASE -1
#endif
#define IN(k) ((ONLY_PHASE < 0 || ONLY_PHASE == (k)) && lo <= (k) && (k) < hi)
#if MK_MULTI
#define SEAM(k) do { } while (0)
#else
#define SEAM(k) do { if (IN(k) && IN((k) + 1)) { if (a.ph_hi > 1000) cg::this_grid().sync(); else GSYNC(); } } while (0)
#endif
    bf16_t* XB = (bf16_t*)(ws + WS_XB); bf16_t* H = (bf16_t*)(ws + WS_H); float* SS = (float*)(ws + WS_SS);
    pg8::StaticOrder S;
#define REPS(k) for (int rep_ = 0; rep_ < ((PROBE_PHASE == (k)) ? 2 : 1); ++rep_)
#define RSYNC() do { if (rep_) GSYNC(); } while (0)
    if (IN(0)) REPS(0) { RSYNC(); phase_tables(a, ws, dob); } SEAM(0);
    if (IN(1)) REPS(1) { RSYNC(); phase_prep(a, ws, dob, L3); __syncthreads(); } SEAM(1);
#if MK_MULTI
    if (IN(2)) REPS(2) { RSYNC();
        phase_toeplitz(dob);
        pg8::Gemm g{XB, (const bf16_t*)(ws + WS_W1), MT, 2 * DFF, 1024, 1024, 1024, 0, 0}; S.init(MT, 2 * DFF, G, (int)blockIdx.x);
        pg8::EpiSwiGLU E{H, SS}; pg8::gemm_phase(L3, g, S, E);
    } SEAM(2);
    if (IN(3)) REPS(3) { RSYNC();
        pg8::Gemm g{H, (const bf16_t*)(ws + WS_W1D), MT, 1024, DFF, DFF, DFF, 0, 0}; S.init(MT, 1024, G, (int)blockIdx.x);
        pg8::EpiRes<true> E{nullptr, nullptr, XB, 0.5f, nullptr, XB, SS + MT}; pg8::gemm_phase(L3, g, S, E, STAG_DOWN);
    } SEAM(3);
#else
    if (IN(2)) {
        phase_toeplitz(dob);
        for (int c = 0; c < FFN_CHUNKS; ++c) {
            const size_t r0 = (size_t)c * FFN_MC;
            { pg8::Gemm g{XB + r0 * DM, (const bf16_t*)(ws + WS_W1), FFN_MC, 2 * DFF, 1024, 1024, 1024, 0, 0}; S.init(FFN_MC, 2 * DFF, G, (int)blockIdx.x);
              pg8::EpiSwiGLU E{H, SS + r0}; pg8::gemm_phase(L3, g, S, E); }
            GSYNC();
            { pg8::Gemm g{H, (const bf16_t*)(ws + WS_W1D), FFN_MC, 1024, DFF, LDH, DFF, 0, 0}; S.init(FFN_MC, 1024, G, (int)blockIdx.x);
              pg8::EpiRes<true> E{nullptr, nullptr, XB + r0 * DM, 0.5f, nullptr, XB + r0 * DM, SS + MT + r0}; pg8::gemm_phase(L3, g, S, E, STAG_DOWN); }
            if (c + 1 < FFN_CHUNKS) GSYNC();
        }
    } SEAM(3);
#endif
    if (IN(4)) REPS(4) { RSYNC();
        pg8::Gemm g{XB, (const bf16_t*)(ws + WS_WIN), MT, 2048, 1024, 1024, 1024, 0, 0}; S.init(MT, 2048, G, (int)blockIdx.x);
        pg8::EpiProj E{SS + MT, (const f32x4*)(ws + WS_ROPE), (bf16_t*)(ws + WS_Q12), (bf16_t*)(ws + WS_K12), (bf16_t*)(ws + WS_V), (bf16_t*)(ws + WS_UH)}; pg8::gemm_phase(L3, g, S, E);
    } SEAM(4);
    if (IN(5)) REPS(5) { RSYNC();
        pg8::Gemm g{(const bf16_t*)(ws + WS_UH), (const bf16_t*)(dob + DO_WSM), MG, 256, 1024, LDU, 1024, 6, 1}; S.init(MG, 256, G, (int)blockIdx.x);
        pg8::EpiS E{(float*)(ws + WS_S)}; pg8::gemm_phase(L3, g, S, E);
    } SEAM(5);
    if (IN(6)) REPS(6) { RSYNC(); phase_chunkscan(ws, dob); phase_attn(a, ws, dob, (char*)lds); } SEAM(6);
    if (IN(7)) REPS(7) { RSYNC();
        pg8::Gemm g{(const bf16_t*)(ws + WS_UH), (const bf16_t*)(dob + DO_BTY), MG, 1024, LDU, LDU, LDU, 6, 4}; S.init(MG, 1024, G, (int)blockIdx.x);
        pg8::EpiY E{(bf16_t*)(ws + WS_Q12)}; pg8::gemm_phase(L3, g, S, E);
    } SEAM(7);
    if (IN(8)) REPS(8) { RSYNC();
        pg8::Gemm g{(const bf16_t*)(ws + WS_Q12), (const bf16_t*)(ws + WS_WGLU), MT, 512, 512, 512, 512, 0, 0}; S.init(MT, 512, G, (int)blockIdx.x);
        pg8::EpiGLU E{(const bf16_t*)(ws + WS_Q12), (bf16_t*)(dob + DO_MIX)}; pg8::gemm_phase(L3, g, S, E);
    } SEAM(8);
    if (IN(9)) REPS(9) { RSYNC();
        pg8::Gemm g{(const bf16_t*)(dob + DO_MIX), (const bf16_t*)(ws + WS_WOUT), MT, 1024, 1024, 1024, 1024, 0, 0}; S.init(MT, 1024, G, (int)blockIdx.x);
        pg8::EpiRes<true> E{nullptr, nullptr, XB, 1.0f, nullptr, XB, SS + 2 * MT}; pg8::gemm_phase(L3, g, S, E, STAG_OUT);
    } SEAM(9);
#if MK_MULTI
    if (IN(10)) REPS(10) { RSYNC();
        pg8::Gemm g{XB, (const bf16_t*)(ws + WS_W2), MT, 2 * DFF, 1024, 1024, 1024, 0, 0}; S.init(MT, 2 * DFF, G, (int)blockIdx.x);
        pg8::EpiSwiGLU E{H, SS + 2 * MT}; pg8::gemm_phase(L3, g, S, E);
    } SEAM(10);
    if (IN(11)) REPS(11) { RSYNC();
        pg8::Gemm g{H, (const bf16_t*)(ws + WS_W2D), MT, 1024, DFF, DFF, DFF, 0, 0}; S.init(MT, 1024, G, (int)blockIdx.x);
        pg8::EpiRes<true> E{nullptr, nullptr, XB, 0.5f, nullptr, XB, nullptr}; pg8::gemm_phase(L3, g, S, E, STAG_DOWN);
    } SEAM(11);
#else
    if (IN(10)) {
        for (int c = 0; c < FFN_CHUNKS; ++c) {
            const size_t r0 = (size_t)c * FFN_MC;
            { pg8::Gemm g{XB + r0 * DM, (const bf16_t*)(ws + WS_W2), FFN_MC, 2 * DFF, 1024, 1024, 1024, 0, 0}; S.init(FFN_MC, 2 * DFF, G, (int)blockIdx.x);
              pg8::EpiSwiGLU E{H, SS + 2 * MT + r0}; pg8::gemm_phase(L3, g, S, E); }
            GSYNC();
            { pg8::Gemm g{H, (const bf16_t*)(ws + WS_W2D), FFN_MC, 1024, DFF, LDH, DFF, 0, 0}; S.init(FFN_MC, 1024, G, (int)blockIdx.x);
              pg8::EpiRes<true> E{nullptr, nullptr, XB + r0 * DM, 0.5f, nullptr, XB + r0 * DM, nullptr}; pg8::gemm_phase(L3, g, S, E, STAG_DOWN); }
            if (c + 1 < FFN_CHUNKS) GSYNC();
        }
    } SEAM(11);
#endif
    if (IN(12)) { phase_final(a, XB); }
#undef IN
#undef SEAM
}

extern "C" void kernel_launch(void* const* d_in, const int* in_sizes, int n_in, void* d_out, int out_size, void* d_ws, size_t ws_size, hipStream_t stream) {
    static int grid = 0;
    if (grid == 0) {
        if (n_in != 28 || in_sizes[0] != MP * DM || out_size != MT * DM || ws_size < WS_END) { fprintf(stderr, "kernel_launch: unexpected shapes n_in %d in0 %d out %d ws %zu\n", n_in, n_in > 0 ? in_sizes[0] : -1, out_size, ws_size); grid = -1; return; }
        int dev = 0, cus = 0, per_cu = 0;
        hipGetDevice(&dev); hipDeviceGetAttribute(&cus, hipDeviceAttributeMultiprocessorCount, dev);
        if (hipFuncSetAttribute((const void*)fwd_kernel, hipFuncAttributeMaxDynamicSharedMemorySize, LDS_BYTES) != hipSuccess) { fprintf(stderr, "kernel_launch: hipFuncSetAttribute failed\n"); grid = -1; return; }
        if (hipOccupancyMaxActiveBlocksPerMultiprocessor(&per_cu, (const void*)fwd_kernel, NTHR, LDS_BYTES) != hipSuccess || per_cu < 1) { fprintf(stderr, "kernel_launch: occupancy query says %d\n", per_cu); per_cu = 1; }
        (void)hipGetLastError();
        grid = cus * 1;
    }
    if (grid < 0) return;
    Args a{};
    for (int i = 0; i < 28; ++i) a.in[i] = (const float*)d_in[i];
    a.out = (float*)d_out; a.ws = (unsigned char*)d_ws;
#if MK_MULTI
    for (int p = 0; p < NPHASE; ++p) { a.ph_lo = p; a.ph_hi = p + 1; hipLaunchKernelGGL(fwd_kernel, dim3(grid), dim3(NTHR), LDS_BYTES, stream, a); }
#else
    a.ph_lo = 0; a.ph_hi = NPHASE;
    if (hipMemsetAsync((char*)d_ws + WS_BAR, 0, 16384, stream) != hipSuccess) { fprintf(stderr, "kernel_launch: memset of the barrier words failed\n"); return; }
    void* args[] = {&a};
    hipError_t e = hipLaunchCooperativeKernel((const void*)fwd_kernel, dim3(grid), dim3(NTHR), args, LDS_BYTES, stream);
    if (e != hipSuccess) fprintf(stderr, "kernel_launch: cooperative launch failed: %s (grid %d)\n", hipGetErrorString(e), grid);
#endif
}
```

```cpp
#include <hip/hip_runtime.h>
#include <hip/hip_cooperative_groups.h>
#include <cstdio>
#include <cstdint>
namespace cg = cooperative_groups;

#ifndef MK_MULTI
#define MK_MULTI 0
#endif

#ifndef PROBE_PHASE
#define PROBE_PHASE -1
#endif
#define LAS __attribute__((address_space(3)))
#define GAS __attribute__((address_space(1)))
typedef unsigned short bf16_t;
typedef short bf16x8 __attribute__((ext_vector_type(8)));
typedef short s16x4 __attribute__((ext_vector_type(4)));
typedef float f32x4 __attribute__((ext_vector_type(4)));
typedef float f32x2 __attribute__((ext_vector_type(2)));
typedef float f32x16 __attribute__((ext_vector_type(16)));
typedef unsigned u32x4 __attribute__((ext_vector_type(4)));
typedef unsigned u32x2 __attribute__((ext_vector_type(2)));

constexpr int DM = 1024, MP = 65536, MT = 98304, LPR = 2048, LSM = 4096, DFF = 2816;
constexpr int NCH = MT / 64;
constexpr int MG = 32 * NCH;
constexpr int LDU = 1280;
constexpr int LDH = DFF + 64;
constexpr float C2 = 0.125f * 1.4426950408889634f;
constexpr float LOG2E = 1.4426950408889634f;

constexpr size_t MiB = (size_t)1 << 20;
constexpr size_t WS_XB = 0;
constexpr size_t WS_H = 192 * MiB;
constexpr size_t WS_Q12 = 192 * MiB;
constexpr size_t WS_K12 = 288 * MiB;
constexpr size_t WS_V = 384 * MiB;
constexpr size_t WS_UH = 480 * MiB;
constexpr size_t WS_S = 600 * MiB;
constexpr size_t WS_W1 = 732 * MiB, WS_W1D = 743 * MiB, WS_WIN = 749 * MiB, WS_WOUT = 753 * MiB, WS_WGLU = 755 * MiB, WS_W2 = 756 * MiB, WS_W2D = 767 * MiB;
constexpr size_t WS_SS = 773 * MiB;
constexpr size_t WS_ROPE = 779 * MiB;
constexpr size_t WS_BBAR = 780 * MiB;
constexpr size_t WS_SCAL = 781 * MiB;
constexpr size_t WS_BAR = 782 * MiB;
constexpr size_t WS_END = 783 * MiB;
constexpr size_t DO_MIX = 0;
constexpr size_t DO_BTY = 192 * MiB;
constexpr size_t DO_WSM = 272 * MiB;
constexpr size_t DO_LPOW = 288 * MiB;
constexpr size_t DO_KK = 292 * MiB;

#define LDS_WAIT() asm volatile("s_waitcnt lgkmcnt(0)" ::: "memory")
#define VM_WAIT() asm volatile("s_waitcnt vmcnt(0)" ::: "memory")
#define MEMFENCE() asm volatile("" ::: "memory")

__device__ __forceinline__ int tidx() { int t = threadIdx.x; asm volatile("" : "+v"(t)); return t; }
__device__ __forceinline__ unsigned cvt_pk_bf16(float lo, float hi) { unsigned r; asm volatile("v_cvt_pk_bf16_f32 %0, %1, %2" : "=v"(r) : "v"(lo), "v"(hi)); return r; }
__device__ __forceinline__ float bf_lo(unsigned w) { return __uint_as_float(w << 16); }
__device__ __forceinline__ float bf_hi(unsigned w) { return __uint_as_float(w & 0xffff0000u); }
__device__ __forceinline__ float fast_rcp(float x) { return __builtin_amdgcn_rcpf(x); }
__device__ __forceinline__ float fast_exp2(float x) { return __builtin_amdgcn_exp2f(x); }
__device__ __forceinline__ float rinv_of(const float* ss, int row) { return rsqrtf(ss[row] * (1.0f / 1024.0f) + 1e-6f); }

namespace pg8 {
constexpr int BM = 256, BK = 64, HALF = 128, HTB = HALF * BK * 2, STAGE_BYTES = 8 * HTB, NXCD = 8, WGM = 4;
__host__ __device__ __forceinline__ int lds_byte(int r, int c) { const int st = (r >> 4) * 2 + (c >> 5), rr = r & 15, cc = c & 31, ob = rr * 64 + cc * 2; return st * 1024 + (ob ^ (((ob >> 9) & 1) << 5)); }
__host__ __device__ __forceinline__ void stage_rc(int b, int& R, int& C) { const int st = b / 1024, sb = b % 1024, swz = sb ^ (((sb >> 9) & 1) << 5); R = (st >> 1) * 16 + swz / 64; C = (st & 1) * 32 + (swz % 64) / 2; }
__host__ __device__ __forceinline__ int perm32(int rho) { const int n = rho >> 4, i = rho & 15; return 8 * (i >> 2) + 4 * n + (i & 3); }
struct Unit { int pm, pn; };
struct Gemm { const bf16_t* A; const bf16_t* Bt; int M, N, K, lda, ldb, gdiv, gtiles; };
struct StaticOrder {
    int nM, nN, nwg, G, c;
    __device__ void init(int M, int N, int G_, int c_) { nM = M / BM; nN = N / BM; nwg = nM * nN; G = G_; c = c_; }
    __device__ bool next(int i, Unit& u) const {
        const long L = (long)i * G + c; if (L >= nwg) return false;
        int wgid = (int)L; { const int q = nwg / NXCD, r = nwg % NXCD, xcd = wgid % NXCD, off = wgid / NXCD; wgid = (xcd < r ? xcd * (q + 1) : r * (q + 1) + (xcd - r) * q) + off; }
        const int nig = WGM * nN, gid = wgid / nig, fm = gid * WGM, gsz = (nM - fm) < WGM ? (nM - fm) : WGM;
        u.pm = fm + ((wgid % nig) % gsz); u.pn = (wgid % nig) / gsz; return true;
    }
};
template <class Epi>
__device__ __forceinline__ void gemm_phase(LAS unsigned char* lds, const Gemm g, const StaticOrder& S, const Epi& E, int stagger_us = 0) {
    if (stagger_us) { const unsigned long long t0 = __builtin_amdgcn_s_memrealtime(), dl = (unsigned long long)(((blockIdx.x >> 3) & 3) * stagger_us * 25);
        while (__builtin_amdgcn_s_memrealtime() - t0 < dl) __builtin_amdgcn_s_sleep(8); }
    const int tid = tidx(), wid = __builtin_amdgcn_readfirstlane(tid >> 6), lane = tid & 63, wr = wid >> 2, wc = wid & 3, fr = lane & 15, fq = lane >> 4;
    const int K = g.K, nt = K / BK;
    unsigned voffA[2], voffB[2];
#pragma unroll
    for (int i = 0; i < 2; ++i) { int R, C; stage_rc(tid * 16 + i * 8192, R, C); const int Rb = (R & ~31) + perm32(R & 31);
        voffA[i] = (unsigned)(R * g.lda + C) * 2u; voffB[i] = (unsigned)(Rb * g.ldb + C) * 2u; }
    const size_t kstep = (size_t)(BK * 2);
    const size_t hstepA = (size_t)HALF * g.lda * 2, hstepB = (size_t)HALF * g.ldb * 2;
    const size_t tstepA = 2 * hstepA, tstepB = 2 * hstepB;
    const unsigned ldsw = (unsigned)wid * 1024u;
    const int aoff = lds_byte(wr * 64 + fr, fq * 8), boff = lds_byte(wc * 32 + fr, fq * 8);
#define PG8_BT(u) ((u).pn + (g.gdiv ? ((u).pm / g.gdiv) * g.gtiles : 0))
#define PG8_SA(b, h) (((b) * 2 + (h)) * HTB)
#define PG8_SB(b, h) ((4 + (b) * 2 + (h)) * HTB)
#define PG8_STAGE(bufoff, gbase, voff) do { _Pragma("unroll") for (int _i = 0; _i < 2; ++_i) \
        __builtin_amdgcn_global_load_lds((const unsigned*)((const char*)(gbase) + (voff)[_i]), (LAS unsigned*)(lds + (bufoff) + ldsw + _i * 8192), 16, 0, 0); } while (0)
#define PG8_LDA(dst, b, h) do { _Pragma("unroll") for (int m = 0; m < 4; ++m) _Pragma("unroll") for (int k = 0; k < 2; ++k) dst[m][k] = *(const LAS bf16x8*)(lds + PG8_SA(b, h) + aoff + m * 2048 + k * 1024); } while (0)
#define PG8_LDB(dst, b, h) do { _Pragma("unroll") for (int n = 0; n < 2; ++n) _Pragma("unroll") for (int k = 0; k < 2; ++k) dst[n][k] = *(const LAS bf16x8*)(lds + PG8_SB(b, h) + boff + n * 2048 + k * 1024); } while (0)
#define PG8_MMA(ai, bj, At, Bt) do { __builtin_amdgcn_s_setprio(1); _Pragma("unroll") for (int m = 0; m < 4; ++m) _Pragma("unroll") for (int n = 0; n < 2; ++n) _Pragma("unroll") for (int k = 0; k < 2; ++k) \
        acc[ai][bj][m][n] = __builtin_amdgcn_mfma_f32_16x16x32_bf16(Bt[n][k], At[m][k], acc[ai][bj][m][n], 0, 0, 0); __builtin_amdgcn_s_setprio(0); } while (0)
#define PG8_WAIT_V(n) asm volatile("s_waitcnt vmcnt(" #n ")" ::: "memory")
#define PG8_WAIT_L(n) asm volatile("s_waitcnt lgkmcnt(" #n ")" ::: "memory")
#define PG8_BAR __builtin_amdgcn_s_barrier()
#define PG8_SCHED __builtin_amdgcn_sched_barrier(0)
    Unit cur, nxt; int ui = 0;
    if (!S.next(0, cur)) return;
    f32x4 acc[2][2][4][2];
#pragma unroll
    for (int a = 0; a < 2; ++a)
#pragma unroll
        for (int b = 0; b < 2; ++b)
#pragma unroll
            for (int m = 0; m < 4; ++m)
#pragma unroll
                for (int n = 0; n < 2; ++n) acc[a][b][m][n] = (f32x4){0.f, 0.f, 0.f, 0.f};
    bf16x8 At[4][2], B0[2][2], B1[2][2];
    const char* cA = (const char*)g.A + (size_t)cur.pm * tstepA; const char* cB = (const char*)g.Bt + (size_t)PG8_BT(cur) * tstepB;
    PG8_STAGE(PG8_SB(0, 0), cB, voffB); PG8_STAGE(PG8_SB(0, 1), cB + hstepB, voffB); PG8_STAGE(PG8_SA(0, 0), cA, voffA); PG8_STAGE(PG8_SA(0, 1), cA + hstepA, voffA);
    if (wr == 1) PG8_BAR;
    PG8_WAIT_V(2); PG8_BAR;
    PG8_STAGE(PG8_SB(1, 0), cB + kstep, voffB); PG8_STAGE(PG8_SA(1, 0), cA + kstep, voffA); PG8_STAGE(PG8_SB(1, 1), cB + hstepB + kstep, voffB);
    PG8_WAIT_V(6); PG8_BAR;
    for (;;) {
        const bool has_next = S.next(ui + 1, nxt);
        const char* nA = has_next ? (const char*)g.A + (size_t)nxt.pm * tstepA : cA; const char* nB = has_next ? (const char*)g.Bt + (size_t)PG8_BT(nxt) * tstepB : cB;
        typename Epi::Pre pre; E.prefetch(pre, cur, wr, fr);
        for (int t = 0; t < nt; t += 2) {
            const bool last = (t == nt - 2);
            const char* a1 = cA + (size_t)(t + 1) * kstep;
            const char* a2 = last ? nA : cA + (size_t)(t + 2) * kstep; const char* b2 = last ? nB : cB + (size_t)(t + 2) * kstep;
            const char* a3 = a2 + kstep; const char* b3 = b2 + kstep;
            PG8_LDB(B0, 0, 0); PG8_LDB(B1, 0, 1); PG8_SCHED; PG8_LDA(At, 0, 0); PG8_STAGE(PG8_SA(1, 1), a1 + hstepA, voffA);
            PG8_WAIT_V(8); PG8_WAIT_L(0); PG8_BAR; PG8_MMA(0, 0, At, B0); PG8_MMA(0, 1, At, B1); PG8_BAR; PG8_SCHED;
            PG8_LDA(At, 0, 1); PG8_STAGE(PG8_SB(0, 0), b2, voffB); PG8_STAGE(PG8_SB(0, 1), b2 + hstepB, voffB); PG8_STAGE(PG8_SA(0, 0), a2, voffA);
            PG8_WAIT_V(8); PG8_WAIT_L(0); PG8_BAR; PG8_MMA(1, 0, At, B0); PG8_MMA(1, 1, At, B1); PG8_BAR; PG8_SCHED;
            PG8_LDB(B0, 1, 0); PG8_LDB(B1, 1, 1); PG8_SCHED; PG8_LDA(At, 1, 0); PG8_STAGE(PG8_SA(0, 1), a2 + hstepA, voffA);
            PG8_WAIT_V(8); PG8_WAIT_L(0); PG8_BAR; PG8_MMA(0, 0, At, B0); PG8_MMA(0, 1, At, B1); PG8_BAR; PG8_SCHED;
            PG8_LDA(At, 1, 1); PG8_STAGE(PG8_SB(1, 0), b3, voffB); PG8_STAGE(PG8_SB(1, 1), b3 + hstepB, voffB); PG8_STAGE(PG8_SA(1, 0), a3, voffA);
            PG8_WAIT_V(8); PG8_WAIT_L(0); PG8_BAR; PG8_MMA(1, 0, At, B0); PG8_MMA(1, 1, At, B1); PG8_BAR; PG8_SCHED;
        }
        if (wr == 0) PG8_BAR;
        E(acc, pre, cur, wr, wc, fr, fq);
        if (!has_next) break;
#pragma unroll
        for (int a = 0; a < 2; ++a)
#pragma unroll
            for (int b = 0; b < 2; ++b)
#pragma unroll
                for (int m = 0; m < 4; ++m)
#pragma unroll
                    for (int n = 0; n < 2; ++n) acc[a][b][m][n] = (f32x4){0.f, 0.f, 0.f, 0.f};
        cur = nxt; cA = nA; cB = nB; ++ui;
        if (wr == 1) PG8_BAR;
    }
    PG8_WAIT_V(0);
    PG8_BAR;
#undef PG8_BT
#undef PG8_SA
#undef PG8_SB
#undef PG8_STAGE
#undef PG8_LDA
#undef PG8_LDB
#undef PG8_MMA
#undef PG8_WAIT_V
#undef PG8_WAIT_L
#undef PG8_BAR
#undef PG8_SCHED
}

typedef f32x4 Acc[2][2][4][2];

struct EpiSwiGLU {
    bf16_t* H; const float* ss;
    struct Pre { float rv[2][4]; };
    __device__ __forceinline__ void prefetch(Pre& p, const Unit& u, int wr, int fr) const {
#pragma unroll
        for (int ai = 0; ai < 2; ++ai)
#pragma unroll
            for (int m = 0; m < 4; ++m) p.rv[ai][m] = ss[u.pm * BM + wr * 64 + fr + ai * HALF + m * 16];
    }
    __device__ __forceinline__ void operator()(const Acc& acc, const Pre& pre, const Unit& u, int wr, int wc, int fr, int fq) const {
        const int row0 = u.pm * BM + wr * 64 + fr, col0 = u.pn * 128 + wc * 32 + 8 * fq;
#pragma unroll
        for (int ai = 0; ai < 2; ++ai)
#pragma unroll
            for (int m = 0; m < 4; ++m) {
                const int row = row0 + ai * HALF + m * 16; const float var = pre.rv[ai][m] * (1.0f / 1024.0f) + 1e-6f, nl = -rsqrtf(var) * LOG2E;
                float hv[8];
#pragma unroll
                for (int n = 0; n < 2; ++n)
#pragma unroll
                    for (int j = 0; j < 4; ++j) { const float gacc = acc[ai][0][m][n][j], uacc = acc[ai][1][m][n][j]; const float e = fast_exp2(gacc * nl);
                        hv[n * 4 + j] = (gacc * uacc) * fast_rcp(fmaf(e, var, var)); }
                u32x4 w; w.x = cvt_pk_bf16(hv[0], hv[1]); w.y = cvt_pk_bf16(hv[2], hv[3]); w.z = cvt_pk_bf16(hv[4], hv[5]); w.w = cvt_pk_bf16(hv[6], hv[7]);
                *(u32x4*)(H + (size_t)row * LDH + col0) = w;
            }
    }
};
template <bool B16> struct EpiRes {
    const float* baseP; const float* baseS; const bf16_t* base16; float alpha; float* out32; bf16_t* out16; float* ss;
    struct Pre {}; __device__ __forceinline__ void prefetch(Pre&, const Unit&, int, int) const {}
    __device__ __forceinline__ void operator()(const Acc& acc, const Pre& pre, const Unit& u, int wr, int wc, int fr, int fq) const {
        const int row0 = u.pm * BM + wr * 64 + fr;
        const GAS float* b32 = (u.pm < MP / BM) ? (const GAS float*)baseP : (const GAS float*)baseS - (size_t)MP * DM;
#pragma unroll
        for (int ai = 0; ai < 2; ++ai) {
            u32x4 p16[4][2]; f32x4 p32[4][2][2];
#pragma unroll
            for (int m = 0; m < 4; ++m)
#pragma unroll
                for (int bj = 0; bj < 2; ++bj) { const size_t off = (size_t)(row0 + ai * HALF + m * 16) * DM + u.pn * BM + bj * HALF + wc * 32 + 8 * fq;
                    if (B16) p16[m][bj] = *(const u32x4*)(base16 + off); else { p32[m][bj][0] = *(const GAS f32x4*)(b32 + off); p32[m][bj][1] = *(const GAS f32x4*)(b32 + off + 4); } }
#pragma unroll
            for (int m = 0; m < 4; ++m) {
                const int row = row0 + ai * HALF + m * 16; float sq = 0.f;
#pragma unroll
                for (int bj = 0; bj < 2; ++bj) {
                    const size_t off = (size_t)row * DM + u.pn * BM + bj * HALF + wc * 32 + 8 * fq;
                    f32x4 b0, b1;
                    if (B16) { const u32x4 w = p16[m][bj]; b0 = (f32x4){bf_lo(w.x), bf_hi(w.x), bf_lo(w.y), bf_hi(w.y)}; b1 = (f32x4){bf_lo(w.z), bf_hi(w.z), bf_lo(w.w), bf_hi(w.w)}; }
                    else { b0 = p32[m][bj][0]; b1 = p32[m][bj][1]; }
                    const f32x4 v0 = b0 + acc[ai][bj][m][0] * alpha, v1 = b1 + acc[ai][bj][m][1] * alpha;
                    sq += (v0.x * v0.x + v0.y * v0.y) + (v0.z * v0.z + v0.w * v0.w) + (v1.x * v1.x + v1.y * v1.y) + (v1.z * v1.z + v1.w * v1.w);
                    if (out32) { *(f32x4*)(out32 + off) = v0; *(f32x4*)(out32 + off + 4) = v1; }
                    if (out16) { u32x4 w; w.x = cvt_pk_bf16(v0.x, v0.y); w.y = cvt_pk_bf16(v0.z, v0.w); w.z = cvt_pk_bf16(v1.x, v1.y); w.w = cvt_pk_bf16(v1.z, v1.w); *(u32x4*)(out16 + off) = w; }
                }
                if (ss) { sq += __shfl_xor(sq, 16); sq += __shfl_xor(sq, 32); if (fq == 0) __hip_atomic_fetch_add(ss + row, sq, __ATOMIC_RELAXED, __HIP_MEMORY_SCOPE_AGENT); }
            }
            MEMFENCE();
        }
    }
};
struct EpiProj {
    const float* ss; const f32x4* rope; bf16_t *Q12, *K12, *V, *UH;
    struct Pre { float rv[2][4]; };
    __device__ __forceinline__ void prefetch(Pre& p, const Unit& u, int wr, int fr) const {
#pragma unroll
        for (int ai = 0; ai < 2; ++ai)
#pragma unroll
            for (int m = 0; m < 4; ++m) p.rv[ai][m] = ss[u.pm * BM + wr * 64 + fr + ai * HALF + m * 16];
    }
    __device__ __forceinline__ void operator()(const Acc& acc, const Pre& pre, const Unit& u, int wr, int wc, int fr, int fq) const {
        const int row0 = u.pm * BM + wr * 64 + fr; const int pn = u.pn;
#pragma unroll
        for (int am = 0; am < 4; ++am) {
            const int ai = am >> 1;
            f32x4 rp[2][4];
            if (pn < 4) {
#pragma unroll
                for (int mm = 0; mm < 2; ++mm) { const int m = (am & 1) * 2 + mm; const int row = row0 + ai * HALF + m * 16; const int pos = row < MP ? (row & (LPR - 1)) : ((row - MP) & (LSM - 1));
                    const f32x4* p = rope + (size_t)pos * 16 + 4 * fq;
#pragma unroll
                    for (int q = 0; q < 4; ++q) rp[mm][q] = p[q]; }
            }
#pragma unroll
            for (int mm = 0; mm < 2; ++mm) {
                const int m = (am & 1) * 2 + mm;
                const int row = row0 + ai * HALF + m * 16; const float ri = rsqrtf(pre.rv[ai][m] * (1.0f / 1024.0f) + 1e-6f);
                if (pn < 4) {
                    const float sc = (pn < 2 ? C2 : 1.0f) * ri;
                    float o1[8], o2[8];
#pragma unroll
                    for (int q = 0; q < 4; ++q) { const f32x4 cs = rp[mm][q];
                        { const int e = 2 * q; const float x1 = acc[ai][0][m][e >> 2][e & 3] * sc, x2 = acc[ai][1][m][e >> 2][e & 3] * sc; o1[e] = x1 * cs.x - x2 * cs.y; o2[e] = x2 * cs.x + x1 * cs.y; }
                        { const int e = 2 * q + 1; const float x1 = acc[ai][0][m][e >> 2][e & 3] * sc, x2 = acc[ai][1][m][e >> 2][e & 3] * sc; o1[e] = x1 * cs.z - x2 * cs.w; o2[e] = x2 * cs.z + x1 * cs.w; } }
                    bf16_t* dst = (pn < 2 ? Q12 : K12) + (size_t)row * 512 + (pn & 1) * 256 + wc * 64 + 8 * fq;
                    u32x4 w; w.x = cvt_pk_bf16(o1[0], o1[1]); w.y = cvt_pk_bf16(o1[2], o1[3]); w.z = cvt_pk_bf16(o1[4], o1[5]); w.w = cvt_pk_bf16(o1[6], o1[7]); *(u32x4*)dst = w;
                    w.x = cvt_pk_bf16(o2[0], o2[1]); w.y = cvt_pk_bf16(o2[2], o2[3]); w.z = cvt_pk_bf16(o2[4], o2[5]); w.w = cvt_pk_bf16(o2[6], o2[7]); *(u32x4*)(dst + 32) = w;
                } else {
#pragma unroll
                    for (int bj = 0; bj < 2; ++bj) {
                        const f32x4 v0 = acc[ai][bj][m][0] * ri, v1 = acc[ai][bj][m][1] * ri;
                        u32x4 w; w.x = cvt_pk_bf16(v0.x, v0.y); w.y = cvt_pk_bf16(v0.z, v0.w); w.z = cvt_pk_bf16(v1.x, v1.y); w.w = cvt_pk_bf16(v1.z, v1.w);
                        const int c0 = (pn & 1) * 256 + bj * HALF + wc * 32 + 8 * fq;
                        if (pn < 6) *(u32x4*)(V + (size_t)row * 512 + c0) = w;
                        else { const int gq = c0 >> 4, hi0 = c0 & 15; *(u32x4*)(UH + ((size_t)gq * NCH + (row >> 6)) * LDU + (row & 63) * 16 + hi0) = w; }
                    }
                }
            }
            MEMFENCE();
        }
    }
};
struct EpiS {
    float* S;
    struct Pre {}; __device__ __forceinline__ void prefetch(Pre&, const Unit&, int, int) const {}
    __device__ __forceinline__ void operator()(const Acc& acc, const Pre& pre, const Unit& u, int wr, int wc, int fr, int fq) const {
        const int row0 = u.pm * BM + wr * 64 + fr;
#pragma unroll
        for (int ai = 0; ai < 2; ++ai)
#pragma unroll
            for (int m = 0; m < 4; ++m) { const int row = row0 + ai * HALF + m * 16;
#pragma unroll
                for (int bj = 0; bj < 2; ++bj) { float* p = S + (size_t)row * 256 + bj * HALF + wc * 32 + 8 * fq; *(f32x4*)p = acc[ai][bj][m][0]; *(f32x4*)(p + 4) = acc[ai][bj][m][1]; } }
    }
};
struct EpiY {
    bf16_t* SG;
    struct Pre {}; __device__ __forceinline__ void prefetch(Pre&, const Unit&, int, int) const {}
    __device__ __forceinline__ void operator()(const Acc& acc, const Pre& pre, const Unit& u, int wr, int wc, int fr, int fq) const {
        const int row0 = u.pm * BM + wr * 64 + fr;
#pragma unroll
        for (int ai = 0; ai < 2; ++ai)
#pragma unroll
            for (int m = 0; m < 4; ++m) { const int row = row0 + ai * HALF + m * 16; const int gq = row / NCH, ch = row - gq * NCH;
#pragma unroll
                for (int bj = 0; bj < 2; ++bj) {
                    const int c0 = u.pn * BM + bj * HALF + wc * 32 + 8 * fq, j = c0 >> 4, ho0 = c0 & 15;
                    float hv[8];
#pragma unroll
                    for (int e = 0; e < 8; ++e) { const float y = acc[ai][bj][m][e >> 2][e & 3]; const float z = 1.5957691216057308f * (y + 0.044715f * y * y * y);
                        hv[e] = y * fast_rcp(1.0f + fast_exp2(-z * LOG2E)); }
                    u32x4 w; w.x = cvt_pk_bf16(hv[0], hv[1]); w.y = cvt_pk_bf16(hv[2], hv[3]); w.z = cvt_pk_bf16(hv[4], hv[5]); w.w = cvt_pk_bf16(hv[6], hv[7]);
                    *(u32x4*)(SG + ((size_t)ch * 64 + j) * 512 + gq * 16 + ho0) = w;
                } }
    }
};
struct EpiGLU {
    const bf16_t* SG; bf16_t* MIX;
    struct Pre {}; __device__ __forceinline__ void prefetch(Pre&, const Unit&, int, int) const {}
    __device__ __forceinline__ void operator()(const Acc& acc, const Pre& pre, const Unit& u, int wr, int wc, int fr, int fq) const {
        const int row0 = u.pm * BM + wr * 64 + fr;
#pragma unroll
        for (int ai = 0; ai < 2; ++ai) {
            u32x4 pre[4][2];
#pragma unroll
            for (int m = 0; m < 4; ++m)
#pragma unroll
                for (int bj = 0; bj < 2; ++bj) pre[m][bj] = *(const u32x4*)(SG + (size_t)(row0 + ai * HALF + m * 16) * 512 + u.pn * BM + bj * HALF + wc * 32 + 8 * fq);
#pragma unroll
            for (int m = 0; m < 4; ++m) { const int row = row0 + ai * HALF + m * 16;
#pragma unroll
                for (int bj = 0; bj < 2; ++bj) {
                    const int c0 = u.pn * BM + bj * HALF + wc * 32 + 8 * fq;
                    const u32x4 sw = pre[m][bj];
                    const float sv[8] = {bf_lo(sw.x), bf_hi(sw.x), bf_lo(sw.y), bf_hi(sw.y), bf_lo(sw.z), bf_hi(sw.z), bf_lo(sw.w), bf_hi(sw.w)};
                    float hv[8];
#pragma unroll
                    for (int e = 0; e < 8; ++e) hv[e] = sv[e] * fast_rcp(1.0f + fast_exp2(-acc[ai][bj][m][e >> 2][e & 3] * LOG2E));
                    u32x4 w; w.x = cvt_pk_bf16(hv[0], hv[1]); w.y = cvt_pk_bf16(hv[2], hv[3]); w.z = cvt_pk_bf16(hv[4], hv[5]); w.w = cvt_pk_bf16(hv[6], hv[7]);
                    *(u32x4*)(MIX + (size_t)row * DM + 512 + c0) = w;
                } }
            MEMFENCE();
        }
    }
};
}

namespace att {
constexpr int NW = 8, QBLK = 32, KVBLK = 64;
constexpr int SHM_V = KVBLK * 128 * 2, SHM_K = KVBLK * 64 * 2;
constexpr int SLOT = SHM_V + SHM_K;
constexpr int OFF_WS = 3 * SLOT, OFF_ST = OFF_WS + NW * 64 * 4, LDS_BYTES = OFF_ST + 65536;
constexpr float THR = 8.f;
#define KSWZ(row, colB) ((row) * 128 + ((colB) ^ ((((row) >> 1) & 7) << 4)))
#define SBAR() __builtin_amdgcn_sched_barrier(0)
__device__ __forceinline__ int crow(int r, int hi) { return (r & 3) + 8 * (r >> 2) + 4 * hi; }
template <bool FIRST>
__device__ __forceinline__ void partialSM(f32x16& p0, f32x16& p1, float& m_reg, float& alpha, f32x16& negm) {
    float pmax = p0[0];
#pragma unroll
    for (int r = 1; r < 16; ++r) pmax = fmaxf(pmax, p0[r]);
#pragma unroll
    for (int r = 0; r < 16; ++r) pmax = fmaxf(pmax, p1[r]);
    { auto rr = __builtin_amdgcn_permlane32_swap(__float_as_uint(pmax), __float_as_uint(pmax), false, false); pmax = fmaxf(__uint_as_float(rr[0]), __uint_as_float(rr[1])); }
    if (!FIRST && __builtin_expect(__all(pmax <= THR), 1)) { alpha = 1.f; }
    else { const float d = FIRST ? pmax : fmaxf(pmax, 0.f); alpha = FIRST ? 1.f : fast_exp2(-d); m_reg += d;
#pragma unroll
        for (int r = 0; r < 16; ++r) { p0[r] -= d; p1[r] -= d; }
#pragma unroll
        for (int r = 0; r < 16; ++r) negm[r] = -m_reg;
        asm volatile("" : "+v"(negm)); }
#pragma unroll
    for (int r = 0; r < 16; ++r) p0[r] = fast_exp2(p0[r]);
}
__device__ __forceinline__ void finishSM(f32x16& p0, f32x16& p1, float alpha, float& l_reg, bf16x8& pa0, bf16x8& pa1, bf16x8& pa2, bf16x8& pa3) {
#pragma unroll
    for (int r = 0; r < 16; ++r) p1[r] = fast_exp2(p1[r]);
    float ps = 0;
#pragma unroll
    for (int r = 0; r < 16; ++r) ps += p0[r];
#pragma unroll
    for (int r = 0; r < 16; ++r) ps += p1[r];
    { auto rr = __builtin_amdgcn_permlane32_swap(__float_as_uint(ps), __float_as_uint(ps), false, false); ps = __uint_as_float(rr[0]) + __uint_as_float(rr[1]); }
    l_reg = l_reg * alpha + ps;
#define PK4(P, BASE, OUT) do { unsigned a0 = cvt_pk_bf16(P[BASE + 0], P[BASE + 1]), a1 = cvt_pk_bf16(P[BASE + 2], P[BASE + 3]);   \
    unsigned b0 = cvt_pk_bf16(P[BASE + 4], P[BASE + 5]), b1 = cvt_pk_bf16(P[BASE + 6], P[BASE + 7]);                              \
    auto r0 = __builtin_amdgcn_permlane32_swap(a0, b0, false, false); auto r1 = __builtin_amdgcn_permlane32_swap(a1, b1, false, false); \
    u32x4 w = {r0[0], r1[0], r0[1], r1[1]}; OUT = *reinterpret_cast<bf16x8*>(&w); } while (0)
    PK4(p0, 0, pa0); PK4(p0, 8, pa1); PK4(p1, 0, pa2); PK4(p1, 8, pa3);
#undef PK4
}
__device__ __forceinline__ void qkt(f32x16& p0, f32x16& p1, const char* Ks, const bf16x8* qr, int r32, int hi, const f32x16& negm) {
    p0 = negm; p1 = negm;
#pragma unroll
    for (int d0 = 0; d0 < 4; ++d0) { const int cb = (d0 * 16 + hi * 8) * 2;
        const bf16x8 b0 = *reinterpret_cast<const bf16x8*>(Ks + KSWZ(r32, cb));
        const bf16x8 b1 = *reinterpret_cast<const bf16x8*>(Ks + KSWZ(32 + r32, cb));
        p0 = __builtin_amdgcn_mfma_f32_32x32x16_bf16(b0, qr[d0], p0, 0, 0, 0);
        p1 = __builtin_amdgcn_mfma_f32_32x32x16_bf16(b1, qr[d0], p1, 0, 0, 0); }
}
__device__ __forceinline__ int v_st(int k, int c) { const int kk = (k & ~0xC) | ((k & 4) << 1) | ((k & 8) >> 1); return ((kk >> 3) * 4 + (c >> 5)) * 512 + ((kk & 7) * 32 + (c & 31)) * 2; }
__device__ __forceinline__ int v_rd_base(int lane) { return ((lane & 3) << 3) | (((lane >> 2) & 3) << 6) | (((lane >> 4) & 1) << 5) | (((lane >> 5) & 1) << 8); }
constexpr int v_rd_off(int d0, int ks, int half) { return d0 * 512 + ks * 4096 + half * 2048; }
template <int OFF> __device__ __forceinline__ s16x4 tr_read(int vb) { s16x4 r; asm volatile("ds_read_b64_tr_b16 %0, %1 offset:%2" : "=&v"(r) : "v"(vb), "i"(OFF) : "memory"); return r; }
#define PV_RD(X, D0) do { X[0] = tr_read<v_rd_off(D0, 0, 0)>(vb); X[1] = tr_read<v_rd_off(D0, 0, 1)>(vb); X[2] = tr_read<v_rd_off(D0, 1, 0)>(vb); X[3] = tr_read<v_rd_off(D0, 1, 1)>(vb); \
    X[4] = tr_read<v_rd_off(D0, 2, 0)>(vb); X[5] = tr_read<v_rd_off(D0, 2, 1)>(vb); X[6] = tr_read<v_rd_off(D0, 3, 0)>(vb); X[7] = tr_read<v_rd_off(D0, 3, 1)>(vb); } while (0)
#define PV_PK(L, H) (bf16x8){L[0], L[1], L[2], L[3], H[0], H[1], H[2], H[3]}
#define PV_MM(OD, X) do { OD = __builtin_amdgcn_mfma_f32_32x32x16_bf16(pa0, PV_PK(X[0], X[1]), OD, 0, 0, 0); OD = __builtin_amdgcn_mfma_f32_32x32x16_bf16(pa1, PV_PK(X[2], X[3]), OD, 0, 0, 0); \
    OD = __builtin_amdgcn_mfma_f32_32x32x16_bf16(pa2, PV_PK(X[4], X[5]), OD, 0, 0, 0); OD = __builtin_amdgcn_mfma_f32_32x32x16_bf16(pa3, PV_PK(X[6], X[7]), OD, 0, 0, 0); } while (0)
__device__ __forceinline__ void pv_d0(f32x16* o, int vb, bf16x8 pa0, bf16x8 pa1, bf16x8 pa2, bf16x8 pa3) {
    s16x4 fa[8], fb[8];
    PV_RD(fa, 0); PV_RD(fb, 1);
    asm volatile("s_waitcnt lgkmcnt(8)" ::: "memory"); SBAR();
    PV_MM(o[0], fa); SBAR();
    PV_RD(fa, 2);
    asm volatile("s_waitcnt lgkmcnt(8)" ::: "memory"); SBAR();
    PV_MM(o[1], fb); SBAR();
    PV_RD(fb, 3);
    asm volatile("s_waitcnt lgkmcnt(8)" ::: "memory"); SBAR();
    PV_MM(o[2], fa); SBAR();
    asm volatile("s_waitcnt lgkmcnt(0)" ::: "memory"); SBAR();
    PV_MM(o[3], fb);
}
#undef PV_RD
#undef PV_PK
#undef PV_MM
__device__ __forceinline__ bf16x8 ld8(const bf16_t* p) { return *reinterpret_cast<const bf16x8*>(p); }

template <int map>
__device__ __forceinline__ void attn_map(const bf16_t* __restrict__ Q12, const bf16_t* __restrict__ K12, const bf16_t* __restrict__ V, bf16_t* __restrict__ MIX,
                                         const float* __restrict__ subg, float lam, long row0, int seq, int h, int q0, char* lds) {
    const int tid = tidx(), wid = tid >> 6, lane = tid & 63, r32 = lane & 31, hi = lane >> 5;
    float* ws = (float*)(lds + OFF_WS) + wid * 64; float* li_l = ws; float* al_l = ws + 32;
    unsigned* stash = (unsigned*)(lds + OFF_ST);
    const int sr = tid >> 4, sc = (tid & 15) * 8, vst0 = v_st(sr, sc), vst1 = v_st(32 + sr, sc);
    const int kr = tid >> 3, kc = (tid & 7) * 8, kst = SHM_V + KSWZ(kr, kc * 2);
    const int vbase = (int)(uintptr_t)lds + v_rd_base(lane);
    const int NT = seq / KVBLK;
    const bf16_t* Vh = V + row0 * 512 + h * 128;
    {
        const bf16_t* Qw = Q12 + (row0 + q0 + wid * QBLK + r32) * 512 + map * 256 + h * 64 + hi * 8;
        const bf16_t* Kh = K12 + row0 * 512 + map * 256 + h * 64;
        bf16x8 qr[4];
#pragma unroll
        for (int d0 = 0; d0 < 4; ++d0) qr[d0] = ld8(Qw + d0 * 16);
        float m_reg = 0.f, l_reg = 0.f; f32x16 o[4] = {}; f32x16 negm = {};
        struct { bf16x8 vs0, vs1, ks; } sr_;
#define SLOAD(k0) do { sr_.vs0 = ld8(&Vh[(long)((k0) + sr) * 512 + sc]); sr_.vs1 = ld8(&Vh[(long)((k0) + 32 + sr) * 512 + sc]); sr_.ks = ld8(&Kh[(long)((k0) + kr) * 512 + kc]); } while (0)
#define SWRITE(so) do { *(bf16x8*)(lds + (so) + vst0) = sr_.vs0; *(bf16x8*)(lds + (so) + vst1) = sr_.vs1; *(bf16x8*)(lds + (so) + kst) = sr_.ks; } while (0)
#define SWAIT() asm volatile("s_waitcnt vmcnt(0)" ::: "memory")
#define RESC(a) do { if (__any((a) < 1.f)) { if (hi == 0) al_l[r32] = (a); asm volatile("s_waitcnt lgkmcnt(0)" ::: "memory"); \
    _Pragma("unroll") for (int d = 0; d < 4; ++d) _Pragma("unroll") for (int r = 0; r < 16; ++r) o[d][r] *= al_l[crow(r, hi)]; } } while (0)
#define KPTR(so) (lds + (so) + SHM_V)
#define ROT() do { const int t_ = s_prev; s_prev = s_cur; s_cur = s_nxt; s_nxt = t_; } while (0)
        f32x16 pA0, pA1, pB0, pB1; float alA, alB; bf16x8 pa0, pa1, pa2, pa3;
        SLOAD(0); asm volatile("s_waitcnt vmcnt(0)" ::: "memory"); SWRITE(0); __syncthreads();
        qkt(pA0, pA1, KPTR(0), qr, r32, hi, negm); partialSM<true>(pA0, pA1, m_reg, alA, negm);
        SLOAD(KVBLK);
        SWAIT(); SWRITE(SLOT); __syncthreads();
        int s_prev = 0, s_cur = SLOT, s_nxt = 2 * SLOT;
        for (int j = 1; j + 1 < NT; j += 2) {
            SBAR(); qkt(pB0, pB1, KPTR(s_cur), qr, r32, hi, negm);
            finishSM(pA0, pA1, alA, l_reg, pa0, pa1, pa2, pa3); SBAR();
            SLOAD((j + 1) * KVBLK); SBAR();
            pv_d0(o, vbase + s_prev, pa0, pa1, pa2, pa3); partialSM<false>(pB0, pB1, m_reg, alB, negm);
            SWAIT(); SWRITE(s_nxt);
            RESC(alB); __syncthreads(); ROT();
            SBAR(); qkt(pA0, pA1, KPTR(s_cur), qr, r32, hi, negm);
            finishSM(pB0, pB1, alB, l_reg, pa0, pa1, pa2, pa3); SBAR();
            SLOAD((j + 2) * KVBLK); SBAR();
            pv_d0(o, vbase + s_prev, pa0, pa1, pa2, pa3); partialSM<false>(pA0, pA1, m_reg, alA, negm);
            SWAIT(); SWRITE(s_nxt);
            RESC(alA); __syncthreads(); ROT();
        }
        SBAR(); qkt(pB0, pB1, KPTR(s_cur), qr, r32, hi, negm);
        finishSM(pA0, pA1, alA, l_reg, pa0, pa1, pa2, pa3); SBAR();
        pv_d0(o, vbase + s_prev, pa0, pa1, pa2, pa3); partialSM<false>(pB0, pB1, m_reg, alB, negm);
        RESC(alB);
        finishSM(pB0, pB1, alB, l_reg, pa0, pa1, pa2, pa3); SBAR();
        pv_d0(o, vbase + s_cur, pa0, pa1, pa2, pa3);
#undef KPTR
#undef ROT
#undef SLOAD
#undef SWRITE
#undef SWAIT
#undef RESC
        if (hi == 0) li_l[r32] = l_reg; asm volatile("s_waitcnt lgkmcnt(0)" ::: "memory");
        float rli[16];
#pragma unroll
        for (int r = 0; r < 16; ++r) rli[r] = fast_rcp(li_l[crow(r, hi)]);
        if (map == 0) {
#pragma unroll
            for (int d0 = 0; d0 < 4; ++d0)
#pragma unroll
                for (int r = 0; r < 16; r += 2) stash[wid * 2048 + (d0 * 8 + (r >> 1)) * 64 + lane] = cvt_pk_bf16(o[d0][r] * rli[r], o[d0][r + 1] * rli[r + 1]);
        } else {
            float ssq[16];
#pragma unroll
            for (int r = 0; r < 16; ++r) ssq[r] = 0.f;
#pragma unroll
            for (int d0 = 0; d0 < 4; ++d0)
#pragma unroll
                for (int r = 0; r < 16; r += 2) { const unsigned w = stash[wid * 2048 + (d0 * 8 + (r >> 1)) * 64 + lane];
                    const float v0 = bf_lo(w) - lam * (o[d0][r] * rli[r]), v1 = bf_hi(w) - lam * (o[d0][r + 1] * rli[r + 1]);
                    o[d0][r] = v0; o[d0][r + 1] = v1; ssq[r] += v0 * v0; ssq[r + 1] += v1 * v1; }
#pragma unroll
            for (int r = 0; r < 16; ++r) { float s = ssq[r]; s += __shfl_xor(s, 1); s += __shfl_xor(s, 2); s += __shfl_xor(s, 4); s += __shfl_xor(s, 8); s += __shfl_xor(s, 16);
                ssq[r] = rsqrtf(s * (1.0f / 128.0f) + 1e-5f) * 0.8f; }
            asm volatile("s_waitcnt lgkmcnt(0)" ::: "memory");
            bf16_t* stg = (bf16_t*)(stash + wid * 2048);
#pragma unroll
            for (int d0 = 0; d0 < 4; ++d0) { const float gn = subg[d0 * 32 + r32];
#pragma unroll
                for (int r = 0; r < 16; ++r) { const unsigned w = cvt_pk_bf16(o[d0][r] * ssq[r] * gn, 0.f); stg[crow(r, hi) * 128 + d0 * 32 + r32] = (bf16_t)(w & 0xffffu); } }
            asm volatile("s_waitcnt lgkmcnt(0)" ::: "memory");
            bf16_t* Ow = MIX + (row0 + q0 + wid * QBLK) * 1024 + h * 128;
#pragma unroll
            for (int i = 0; i < 8; ++i) { const int row = i * 4 + (lane >> 4), ch = lane & 15; const u32x4 v = *(const u32x4*)(stg + row * 128 + ch * 8); *(u32x4*)(Ow + (long)row * 1024 + ch * 8) = v; }
        }
        __syncthreads();
    }
}
__device__ __forceinline__ void attn_unit(const bf16_t* __restrict__ Q12, const bf16_t* __restrict__ K12, const bf16_t* __restrict__ V, bf16_t* __restrict__ MIX,
                                          const float* __restrict__ subg, float lam, long row0, int seq, int h, int q0, char* lds) {
    attn_map<0>(Q12, K12, V, MIX, subg, lam, row0, seq, h, q0, lds);
    attn_map<1>(Q12, K12, V, MIX, subg, lam, row0, seq, h, q0, lds);
}
#undef SBAR
}

struct Args { const float* in[28]; float* out; unsigned char* ws; int ph_lo, ph_hi; };
enum { I_XP = 0, I_XS, I_N1, I_G1, I_U1, I_D1, I_MIXN, I_WIN, I_LQ1, I_LK1, I_LQ2, I_LK2, I_SUBN, I_ARE, I_AIM, I_LDT, I_BRE, I_BIM, I_CRE, I_CIM, I_SSMD, I_WGLU, I_WOUT, I_N2, I_G2, I_U2, I_D2, I_FN };
constexpr int NPHASE = 13;
constexpr int FFN_CHUNKS = 1, FFN_MC = MT / FFN_CHUNKS;
#ifndef STAG_DOWN
#define STAG_DOWN 0
#endif
#ifndef STAG_OUT
#define STAG_OUT 0
#endif
constexpr int LDS_BYTES = 147456;
constexpr int NTHR = 512;

struct cplx { double re, im; };
__device__ __forceinline__ cplx cmul(cplx a, cplx b) { return {a.re * b.re - a.im * b.im, a.re * b.im + a.im * b.re}; }
__device__ __forceinline__ void sincos_rev(double r, double& s, double& c) {
    const double x = r * 6.283185307179586476925 * 0.125, x2 = x * x;
    double sp = 1.0 / 6227020800.0; sp = sp * (-x2) + 1.0 / 39916800.0; sp = sp * (-x2) + 1.0 / 362880.0; sp = sp * (-x2) + 1.0 / 5040.0; sp = sp * (-x2) + 1.0 / 120.0; sp = sp * (-x2) + 1.0 / 6.0; sp = sp * (-x2) + 1.0; sp *= x;
    double cp = 1.0 / 87178291200.0; cp = cp * (-x2) + 1.0 / 479001600.0; cp = cp * (-x2) + 1.0 / 3628800.0; cp = cp * (-x2) + 1.0 / 40320.0; cp = cp * (-x2) + 1.0 / 720.0; cp = cp * (-x2) + 1.0 / 24.0; cp = cp * (-x2) + 0.5; cp = 1.0 - cp * x2;
#pragma unroll
    for (int i = 0; i < 3; ++i) { const double s2 = 2.0 * sp * cp, c2 = 1.0 - 2.0 * sp * sp; sp = s2; cp = c2; }
    s = sp; c = cp;
}
__device__ __forceinline__ void sincos_big(double ang, double& s, double& c) { const double t = ang * 0.15915494309189533576888; sincos_rev(t - rint(t), s, c); }

__device__ __forceinline__ void phase_tables(const Args& a, unsigned char* ws, unsigned char* dob) {
    const int gt = blockIdx.x * NTHR + tidx(), GN = gridDim.x * NTHR;
    f32x2* LPOW = (f32x2*)(dob + DO_LPOW); f32x2* BBAR = (f32x2*)(ws + WS_BBAR); f32x2* ROPE = (f32x2*)(ws + WS_ROPE);
    const float *are = a.in[I_ARE], *aim = a.in[I_AIM], *ldt = a.in[I_LDT], *bre = a.in[I_BRE], *bim = a.in[I_BIM];
    for (int i = gt; i < 4096 * 65; i += GN) { const int s = i / 65, k = i - s * 65, gq = s >> 7, dir = (s >> 6) & 1, p = s & 63, idx = (dir * 32 + gq) * 64 + p;
        const double dt = exp((double)ldt[idx]); const double mag = exp((double)k * (double)are[idx] * dt); double sn, cs; sincos_big((double)k * (double)aim[idx] * dt, sn, cs);
        LPOW[i] = (f32x2){(float)(mag * cs), (float)(mag * sn)}; }
    for (int i = gt; i < 4096 * 16; i += GN) { const int s = i >> 4, hh = i & 15, gq = s >> 7, dir = (s >> 6) & 1, p = s & 63, idx = (dir * 32 + gq) * 64 + p;
        const double ar = are[idx], ai = aim[idx], dt = exp((double)ldt[idx]); const double mag = exp(ar * dt); double sn, cs; sincos_big(ai * dt, sn, cs);
        const cplx num = {mag * cs - 1.0, mag * sn}; const double den = ar * ar + ai * ai; const cplx coef = {(num.re * ar + num.im * ai) / den, (num.im * ar - num.re * ai) / den};
        const cplx b = {(double)bre[(size_t)idx * 16 + hh], (double)bim[(size_t)idx * 16 + hh]}; const cplx r = cmul(coef, b);
        BBAR[i] = (f32x2){(float)r.re, (float)r.im}; }
    for (int i = gt; i < 4096 * 32; i += GN) { const int pos = i >> 5, j = i & 31; const float inv = powf(10000.0f, -(float)j / 32.0f); const float ang = (float)pos * inv;
        double sn, cs; sincos_big((double)ang, sn, cs); ROPE[i] = (f32x2){(float)cs, (float)sn}; }
    if (gt == 0) { float s1 = 0.f, s2 = 0.f; for (int i = 0; i < 64; ++i) { s1 += a.in[I_LQ1][i] * a.in[I_LK1][i]; s2 += a.in[I_LQ2][i] * a.in[I_LK2][i]; }
        ((float*)(ws + WS_SCAL))[0] = expf(s1) - expf(s2) + 0.2f; }
}
__device__ __forceinline__ unsigned f2bf(float f) { unsigned u = __builtin_bit_cast(unsigned, f); return (u + 0x7fffu + ((u >> 16) & 1u)) >> 16; }
__device__ __forceinline__ unsigned pk2(float lo, float hi) { return f2bf(lo) | (f2bf(hi) << 16); }
__device__ __forceinline__ void tr_item(const float* W, int N, bf16_t* WT, int ldt, int k0, int n0, int drow0, const float* gain, LAS float* scr, int lane) {
    { const int r8 = lane >> 3, c4 = (lane & 7) * 4; f32x4 v[8];
#pragma unroll
      for (int i = 0; i < 8; ++i) v[i] = *(const f32x4*)(W + (size_t)(k0 + i * 8 + r8) * N + n0 + c4);
#pragma unroll
      for (int i = 0; i < 8; ++i) { const int kk = i * 8 + r8; const float g = gain ? gain[k0 + kk] : 1.0f; LAS float* d = scr + kk * 33 + c4;
          d[0] = v[i].x * g; d[1] = v[i].y * g; d[2] = v[i].z * g; d[3] = v[i].w * g; } }
    LDS_WAIT(); MEMFENCE();
    const int c = lane & 7;
#pragma unroll
    for (int j = 0; j < 4; ++j) { const int n = (lane >> 3) + 8 * j; const LAS float* s = scr + (8 * c) * 33 + n;
        u32x4 o; o.x = pk2(s[0 * 33], s[1 * 33]); o.y = pk2(s[2 * 33], s[3 * 33]); o.z = pk2(s[4 * 33], s[5 * 33]); o.w = pk2(s[6 * 33], s[7 * 33]);
        *(u32x4*)(WT + (size_t)(drow0 + n) * ldt + k0 + 8 * c) = o; }
    LDS_WAIT(); MEMFENCE();
}
__device__ __forceinline__ float wave_sum(float v) {
#pragma unroll
    for (int o = 1; o < 64; o <<= 1) v += __shfl_xor(v, o);
    return v;
}
__device__ __forceinline__ void phase_prep(const Args& a, unsigned char* ws, unsigned char* dob, LAS unsigned char* lds) {
    const int tid = tidx(), lane = tid & 63, wave = tid >> 6;
    const int gw = blockIdx.x * 8 + wave, NGW = gridDim.x * 8;
    const int gt = blockIdx.x * NTHR + tid, GN = gridDim.x * NTHR;
    LAS float* scr = (LAS float*)(lds + wave * 16384);
    constexpr int I_FF = 16 * 88, I_FD = 44 * 32, I_IN = 16 * 64, I_OUT = 16 * 32, I_GLU = 8 * 16;
    static_assert(I_FF == I_FD, "item counts");
    constexpr int NITEMS = 6 * I_FF + I_IN + I_OUT + I_GLU;
    for (int it = gw; it < NITEMS; it += NGW) {
        int r = it;
        if (r < 6 * I_FF) {
            const int blk = r / I_FF, layer = blk / 3, kind = blk % 3; r -= blk * I_FF;
            const float* gain = a.in[layer ? I_N2 : I_N1];
            if (kind < 2) { const int kb = r / 88, nb = r % 88, n0 = nb * 32; const int drow0 = 256 * (n0 >> 7) + 128 * kind + (n0 & 127);
                tr_item(a.in[(layer ? I_G2 : I_G1) + kind], DFF, (bf16_t*)(ws + (layer ? WS_W2 : WS_W1)), 1024, kb * 64, n0, drow0, gain, scr, lane); }
            else { const int kb = r / 32, nb = r % 32; tr_item(a.in[layer ? I_D2 : I_D1], 1024, (bf16_t*)(ws + (layer ? WS_W2D : WS_W1D)), DFF, kb * 64, nb * 32, nb * 32, nullptr, scr, lane); }
            continue;
        }
        r -= 6 * I_FF;
        if (r < I_IN) { const int kb = r / 64, nb = r % 64, n0 = nb * 32; int drow0 = n0;
            if (n0 < 1024) { const int L = n0 & 255; drow0 = (n0 & ~255) + ((L >> 5) & 1) * 128 + (L >> 6) * 32; }
            tr_item(a.in[I_WIN], 2048, (bf16_t*)(ws + WS_WIN), 1024, kb * 64, n0, drow0, a.in[I_MIXN], scr, lane); continue; }
        r -= I_IN;
        if (r < I_OUT) { const int kb = r / 32, nb = r % 32; tr_item(a.in[I_WOUT], 1024, (bf16_t*)(ws + WS_WOUT), 1024, kb * 64, nb * 32, nb * 32, nullptr, scr, lane); continue; }
        r -= I_OUT;
        { const int kb = r / 16, nb = r % 16; tr_item(a.in[I_WGLU], 512, (bf16_t*)(ws + WS_WGLU), 512, kb * 64, nb * 32, nb * 32, nullptr, scr, lane); }
    }
    const f32x2* LPOW = (const f32x2*)(dob + DO_LPOW); const f32x2* BBAR = (const f32x2*)(ws + WS_BBAR);
    const float *cre = a.in[I_CRE], *cim = a.in[I_CIM];
    float* KK = (float*)(dob + DO_KK);
    for (int i = gt; i < 32 * 2 * 64 * 16 * 2; i += GN) { const int ph = i & 1, rest = i >> 1, ho = rest & 15, k = (rest >> 4) & 63, dir = (rest >> 10) & 1, gq = rest >> 11;
        const int s0 = (gq * 2 + dir) * 64; const size_t cb = ((size_t)(dir * 32 + gq) * 16 + ho) * 64;
        float accv[16];
#pragma unroll
        for (int e = 0; e < 16; ++e) accv[e] = 0.f;
        for (int p = ph * 32; p < ph * 32 + 32; ++p) { const f32x2 L = LPOW[(size_t)(s0 + p) * 65 + k]; const float cr = cre[cb + p], ci = cim[cb + p];
            const float tr = cr * L.x - ci * L.y, ti = cr * L.y + ci * L.x; const f32x2* bb = BBAR + (size_t)(s0 + p) * 16;
#pragma unroll
            for (int e = 0; e < 16; ++e) { const f32x2 b = bb[e]; accv[e] += tr * b.x - ti * b.y; } }
#pragma unroll
        for (int e = 0; e < 16; ++e) accv[e] += __shfl_xor(accv[e], 1);
        if (dir == 0 && k == 0) accv[ho] += a.in[I_SSMD][gq * 16 + ho];
        float* dst = KK + (((size_t)(gq * 2 + dir) * 64 + k) * 16 + ho) * 16 + ph * 8;
        if (ph == 0) { *(f32x4*)dst = (f32x4){accv[0], accv[1], accv[2], accv[3]}; *(f32x4*)(dst + 4) = (f32x4){accv[4], accv[5], accv[6], accv[7]}; }
        else { *(f32x4*)dst = (f32x4){accv[8], accv[9], accv[10], accv[11]}; *(f32x4*)(dst + 4) = (f32x4){accv[12], accv[13], accv[14], accv[15]}; } }
    bf16_t* WSM = (bf16_t*)(dob + DO_WSM);
    for (int i = gt; i < 32 * 256 * 64 * 2; i += GN) { const int half = i & 1, ii = (i >> 1) & 63, n = (i >> 7) & 255, gq = i >> 15; const int dir = n >> 7, ri = (n >> 6) & 1, p = n & 63;
        const int s = (gq * 2 + dir) * 64 + p; const f32x2 L = LPOW[(size_t)s * 65 + (dir ? ii : 63 - ii)]; const f32x2* bb = BBAR + (size_t)s * 16 + half * 8;
        float v[8];
#pragma unroll
        for (int e = 0; e < 8; ++e) { const f32x2 b = bb[e]; v[e] = ri ? (L.x * b.y + L.y * b.x) : (L.x * b.x - L.y * b.y); }
        u32x4 w; w.x = pk2(v[0], v[1]); w.y = pk2(v[2], v[3]); w.z = pk2(v[4], v[5]); w.w = pk2(v[6], v[7]);
        *(u32x4*)(WSM + ((size_t)(gq * 256 + n)) * 1024 + ii * 16 + half * 8) = w; }
    bf16_t* BTY = (bf16_t*)(dob + DO_BTY);
    for (int i = gt; i < 32 * 1024 * 32; i += GN) { const int pb = i & 7, ri = (i >> 3) & 1, dir = (i >> 4) & 1, n = (i >> 5) & 1023, gq = i >> 15; const int j = n >> 4, ho = n & 15;
        const int s0 = (gq * 2 + dir) * 64 + pb * 8; const size_t cb = ((size_t)(dir * 32 + gq) * 16 + ho) * 64 + pb * 8; const int e = dir ? 64 - j : j + 1;
        float v[8];
#pragma unroll
        for (int q = 0; q < 8; ++q) { const f32x2 L = LPOW[(size_t)(s0 + q) * 65 + e]; const float cr = cre[cb + q], ci = cim[cb + q]; v[q] = ri ? -(cr * L.y + ci * L.x) : (cr * L.x - ci * L.y); }
        u32x4 w; w.x = pk2(v[0], v[1]); w.y = pk2(v[2], v[3]); w.z = pk2(v[4], v[5]); w.w = pk2(v[6], v[7]);
        *(u32x4*)(BTY + ((size_t)(gq * 1024 + n)) * LDU + 1024 + dir * 128 + ri * 64 + pb * 8) = w; }
    bf16_t* XB = (bf16_t*)(ws + WS_XB); float* SS = (float*)(ws + WS_SS);
    for (int m = gw; m < MT; m += 2 * NGW) {
        const int m2 = (m + NGW < MT) ? m + NGW : m;
        const float* xr0 = m < MP ? a.in[I_XP] + (size_t)m * DM : a.in[I_XS] + (size_t)(m - MP) * DM;
        const float* xr1 = m2 < MP ? a.in[I_XP] + (size_t)m2 * DM : a.in[I_XS] + (size_t)(m2 - MP) * DM;
        f32x4 v[2][4];
#pragma unroll
        for (int j = 0; j < 4; ++j) { v[0][j] = ((const f32x4*)xr0)[lane + 64 * j]; v[1][j] = ((const f32x4*)xr1)[lane + 64 * j]; }
#pragma unroll
        for (int r = 0; r < 2; ++r) { const int mm = r ? m2 : m; float s = 0.f;
#pragma unroll
            for (int j = 0; j < 4; ++j) s += (v[r][j].x * v[r][j].x + v[r][j].y * v[r][j].y) + (v[r][j].z * v[r][j].z + v[r][j].w * v[r][j].w);
            s = wave_sum(s);
            u32x2* o8 = (u32x2*)(XB + (size_t)mm * DM) + lane;
#pragma unroll
            for (int j = 0; j < 4; ++j) o8[64 * j] = (u32x2){pk2(v[r][j].x, v[r][j].y), pk2(v[r][j].z, v[r][j].w)};
            if (lane < 2) SS[(size_t)(lane + 1) * MT + mm] = 0.f;
            if (lane == 0) SS[mm] = s; }
    }
}
__device__ __forceinline__ void phase_toeplitz(unsigned char* dob) {
    const int gt = blockIdx.x * NTHR + tidx(), GN = gridDim.x * NTHR;
    const float* KK = (const float*)(dob + DO_KK); bf16_t* BTY = (bf16_t*)(dob + DO_BTY);
#pragma unroll 4
    for (int it = gt; it < 32 * 1024 * 128; it += GN) { const int half = it & 1, i = (it >> 1) & 63, n = (it >> 7) & 1023, gq = it >> 17; const int j = n >> 4, ho = n & 15;
        const int kf = j >= i ? j - i : 0, kb = i >= j ? i - j : 0; const float mf = j >= i ? 1.f : 0.f, mb = i >= j ? 1.f : 0.f;
        const float* sf = KK + (((size_t)(gq * 2 + 0) * 64 + kf) * 16 + ho) * 16 + half * 8; const float* sb = KK + (((size_t)(gq * 2 + 1) * 64 + kb) * 16 + ho) * 16 + half * 8;
        const f32x4 f0 = *(const f32x4*)sf, f1 = *(const f32x4*)(sf + 4), b0 = *(const f32x4*)sb, b1 = *(const f32x4*)(sb + 4);
        const f32x4 v0 = f0 * mf + b0 * mb, v1 = f1 * mf + b1 * mb;
        u32x4 w; w.x = pk2(v0.x, v0.y); w.y = pk2(v0.z, v0.w); w.z = pk2(v1.x, v1.y); w.w = pk2(v1.z, v1.w);
        *(u32x4*)(BTY + ((size_t)(gq * 1024 + n)) * LDU + i * 16 + half * 8) = w; }
}
__device__ __forceinline__ void phase_chunkscan(unsigned char* ws, unsigned char* dob) {
    const int gt = blockIdx.x * NTHR + tidx(), GN = gridDim.x * NTHR;
    const f32x2* LPOW = (const f32x2*)(dob + DO_LPOW); const float* S = (const float*)(ws + WS_S); bf16_t* UH = (bf16_t*)(ws + WS_UH);
    for (int it = gt; it < 32 * 40 * 128; it += GN) { const int p = it & 63, dir = (it >> 6) & 1, rest = it >> 7, bt = rest % 40, gq = rest / 40;
        const int c0 = bt < 32 ? bt * 32 : 1024 + (bt - 32) * 64, nc = bt < 32 ? 32 : 64;
        const f32x2 L = LPOW[(size_t)((gq * 2 + dir) * 64 + p) * 65 + 64];
        float hr = 0.f, hi_ = 0.f;
        for (int cb = 0; cb < nc; cb += 8) {
            float sr[8], si[8];
#pragma unroll
            for (int q = 0; q < 8; ++q) { const int cc = cb + q, c = dir ? nc - 1 - cc : cc; const size_t row = (size_t)gq * NCH + c0 + c;
                sr[q] = S[row * 256 + dir * 128 + p]; si[q] = S[row * 256 + dir * 128 + 64 + p]; }
#pragma unroll
            for (int q = 0; q < 8; ++q) { const int cc = cb + q, c = dir ? nc - 1 - cc : cc; const size_t row = (size_t)gq * NCH + c0 + c;
                bf16_t* d = UH + row * LDU + 1024 + dir * 128 + p; d[0] = (bf16_t)f2bf(hr); d[64] = (bf16_t)f2bf(hi_);
                const float nr = L.x * hr - L.y * hi_ + sr[q], ni = L.x * hi_ + L.y * hr + si[q]; hr = nr; hi_ = ni; }
        } }
}
__device__ __forceinline__ void phase_attn(const Args& a, unsigned char* ws, unsigned char* dob, char* lds) {
    const float lam = ((const float*)(ws + WS_SCAL))[0];
    const bf16_t* Q12 = (const bf16_t*)(ws + WS_Q12); const bf16_t* K12 = (const bf16_t*)(ws + WS_K12); const bf16_t* V = (const bf16_t*)(ws + WS_V); bf16_t* MIX = (bf16_t*)(dob + DO_MIX);
    for (int u = blockIdx.x; u < 1536; u += gridDim.x) {
        long row0; int seq, h, q0;
        if (u < 512) { const int i = u >> 8, cc = u & 255, x = cc & 7, j = cc >> 3; const int bh = (i * 8 + x) * 2 + (j >> 4), qb = j & 15; row0 = MP + (long)(bh >> 2) * LSM; seq = LSM; h = bh & 3; q0 = qb * 256; }
        else { const int v = u - 512, i = v >> 8, cc = v & 255, x = cc & 7, j = cc >> 3; const int bh = (i * 8 + x) * 4 + (j >> 3), qb = j & 7; row0 = (long)(bh >> 2) * LPR; seq = LPR; h = bh & 3; q0 = qb * 256; }
        att::attn_unit(Q12, K12, V, MIX, a.in[I_SUBN], lam, row0, seq, h, q0, lds);
    }
}
__device__ __forceinline__ void phase_final(const Args& a, const bf16_t* XB) {
    const int tid = tidx(), lane = tid & 63, gw = blockIdx.x * 8 + (tid >> 6), NGW = gridDim.x * 8;
    const f32x4* gp = (const f32x4*)a.in[I_FN] + 2 * lane; f32x4 gv[2][2];
#pragma unroll
    for (int j = 0; j < 2; ++j) { gv[j][0] = gp[128 * j]; gv[j][1] = gp[128 * j + 1]; }
    for (int m = gw; m < MT; m += 2 * NGW) {
        const int m2 = m + NGW; const bool has2 = m2 < MT;
        u32x4 w[2][2];
#pragma unroll
        for (int j = 0; j < 2; ++j) { w[0][j] = ((const u32x4*)(XB + (size_t)m * DM))[lane + 64 * j]; w[1][j] = has2 ? ((const u32x4*)(XB + (size_t)m2 * DM))[lane + 64 * j] : (u32x4){0u, 0u, 0u, 0u}; }
#pragma unroll
        for (int r = 0; r < 2; ++r) { if (r == 1 && !has2) break;
            f32x4 v[2][2]; float s = 0.f;
#pragma unroll
            for (int j = 0; j < 2; ++j) { const u32x4 q = w[r][j]; v[j][0] = (f32x4){bf_lo(q.x), bf_hi(q.x), bf_lo(q.y), bf_hi(q.y)}; v[j][1] = (f32x4){bf_lo(q.z), bf_hi(q.z), bf_lo(q.w), bf_hi(q.w)};
                s += (v[j][0].x * v[j][0].x + v[j][0].y * v[j][0].y) + (v[j][0].z * v[j][0].z + v[j][0].w * v[j][0].w) + (v[j][1].x * v[j][1].x + v[j][1].y * v[j][1].y) + (v[j][1].z * v[j][1].z + v[j][1].w * v[j][1].w); }
            const float ri = rsqrtf(wave_sum(s) * (1.0f / 1024.0f) + 1e-6f);
            f32x4* o = (f32x4*)(a.out + (size_t)(r ? m2 : m) * DM) + 2 * lane;
#pragma unroll
            for (int j = 0; j < 2; ++j) { o[128 * j] = v[j][0] * ri * gv[j][0]; o[128 * j + 1] = v[j][1] * ri * gv[j][1]; } }
    }
}


#define XB_TMO      128
#define XB_XCNT(j)  (256  + 64 * (j))
#define XB_XSUB(j)  (1280 + 64 * (j))
#define XB_XGEN(j)  (2304 + 64 * (j))
#define XB_TOP      3328
#define XB_TOPGEN   3392
#define XCD_BAR_WORDS 3456
#define XB_SPIN_CAP (1u << 22)
__device__ __forceinline__ unsigned xb_ld(unsigned* p)              { return __hip_atomic_load(p, __ATOMIC_RELAXED, __HIP_MEMORY_SCOPE_AGENT); }
__device__ __forceinline__ unsigned xb_add(unsigned* p, unsigned v) { return __hip_atomic_fetch_add(p, v, __ATOMIC_RELAXED, __HIP_MEMORY_SCOPE_AGENT); }
__device__ __forceinline__ unsigned xb_xcc_id() { return (unsigned)__builtin_amdgcn_s_getreg((3 << 11) | 20) & 0xFu; }
#define XB_SPIN(cond, bar) do { unsigned _sp = 0; while (cond) { __builtin_amdgcn_s_sleep(1); \
    if ((++_sp & 255u) == 0u) { if (xb_ld(&(bar)[XB_TMO])) break; if (_sp > XB_SPIN_CAP) { atomicAdd(&(bar)[XB_TMO], 1u); break; } } } } while (0)
struct XcdBarrier { unsigned* bar; unsigned x; volatile LAS unsigned* st; };
__device__ __forceinline__ XcdBarrier xcd_barrier_post(unsigned* bar, volatile LAS unsigned* st) {
    XcdBarrier b; b.bar = bar; b.x = xb_xcc_id(); b.st = st;
    if (threadIdx.x == 0) (void)xb_add(&bar[XB_XCNT(b.x)], 1u);
    return b;
}
__device__ __forceinline__ void xcd_barrier_complete(unsigned* bar, unsigned x, unsigned& nloc, unsigned& nx) {
    const unsigned G = gridDim.x * gridDim.y * gridDim.z;
    unsigned sum, cnt, mine, sp = 0u;
    for (;;) {
        sum = 0u; cnt = 0u; mine = 0u;
#pragma unroll
        for (unsigned j = 0; j < 16; ++j) { const unsigned c = xb_ld(&bar[XB_XCNT(j)]); sum += c; cnt += (c > 0u) ? 1u : 0u; mine = (j == x) ? c : mine; }
        if (sum == G) break;
        __builtin_amdgcn_s_sleep(1);
        if ((++sp & 255u) == 0u) { if (xb_ld(&bar[XB_TMO])) break; if (sp > XB_SPIN_CAP) { atomicAdd(&bar[XB_TMO], 1u); break; } }
    }
    nloc = mine > 0u ? mine : 1u; nx = cnt > 0u ? cnt : 1u;
}
__device__ __forceinline__ void xcd_barrier(const XcdBarrier& b) {
    asm volatile("s_waitcnt vmcnt(0)" ::: "memory");
    __syncthreads();
    if (threadIdx.x == 0) {
        unsigned* bar = b.bar;
        __builtin_amdgcn_s_waitcnt(0);
        unsigned nloc = b.st[0], nx = b.st[1];
        if (nloc == 0u) { xcd_barrier_complete(bar, b.x, nloc, nx); b.st[0] = nloc; b.st[1] = nx; }
        const unsigned old = xb_add(&bar[XB_XSUB(b.x)], 1u);
        const unsigned gen = old / nloc;
        if (old + 1u == (gen + 1u) * nloc) {
            __builtin_amdgcn_fence(__ATOMIC_RELEASE, "agent");
            asm volatile("s_waitcnt vmcnt(0)" ::: "memory");
            const unsigned og = xb_add(&bar[XB_TOP], 1u);
            const unsigned tg = og / nx;
            if (og + 1u == (tg + 1u) * nx) xb_add(&bar[XB_TOPGEN], 1u);
            else XB_SPIN(xb_ld(&bar[XB_TOPGEN]) == tg, bar);
            __builtin_amdgcn_fence(__ATOMIC_ACQUIRE, "agent");
            xb_add(&bar[XB_XGEN(b.x)], 1u);
            asm volatile("s_waitcnt vmcnt(0)" ::: "memory");
        } else {
            XB_SPIN(xb_ld(&bar[XB_XGEN(b.x)]) == gen, bar);
            __builtin_amdgcn_fence(__ATOMIC_ACQUIRE, "agent");
            asm volatile("s_waitcnt vmcnt(0)" ::: "memory");
        }
    }
    __syncthreads();
}

__global__ void __launch_bounds__(NTHR, 2) fwd_kernel(Args a) {
    extern __shared__ __attribute__((aligned(16))) unsigned char lds[];
    LAS unsigned char* L3 = (LAS unsigned char*)lds;
    unsigned char* ws = a.ws; unsigned char* dob = (unsigned char*)a.out;
    const int G = gridDim.x, lo = a.ph_lo, hi = a.ph_hi;
    volatile LAS unsigned* bst = (volatile LAS unsigned*)(L3 + LDS_BYTES - 64);
    if (threadIdx.x < 2) bst[threadIdx.x] = 0u;
    __syncthreads();
    XcdBarrier xbar = xcd_barrier_post((unsigned*)(ws + WS_BAR), bst);
#define GSYNC() xcd_barrier(xbar)
#ifndef ONLY_PHASE
#define ONLY_PHASE -1
#endif
#define IN(k) ((ONLY_PHASE < 0 || ONLY_PHASE == (k)) && lo <= (k) && (k) < hi)
#if MK_MULTI
#define SEAM(k) do { } while (0)
#else
#define SEAM(k) do { if (IN(k) && IN((k) + 1)) { if (a.ph_hi > 1000) cg::this_grid().sync(); else GSYNC(); } } while (0)
#endif
    bf16_t* XB = (bf16_t*)(ws + WS_XB); bf16_t* H = (bf16_t*)(ws + WS_H); float* SS = (float*)(ws + WS_SS);
    pg8::StaticOrder S;
#define REPS(k) for (int rep_ = 0; rep_ < ((PROBE_PHASE == (k)) ? 2 : 1); ++rep_)
#define RSYNC() do { if (rep_) GSYNC(); } while (0)
    if (IN(0)) REPS(0) { RSYNC(); phase_tables(a, ws, dob); } SEAM(0);
    if (IN(1)) REPS(1) { RSYNC(); phase_prep(a, ws, dob, L3); __syncthreads(); } SEAM(1);
#if MK_MULTI
    if (IN(2)) REPS(2) { RSYNC();
        phase_toeplitz(dob);
        pg8::Gemm g{XB, (const bf16_t*)(ws + WS_W1), MT, 2 * DFF, 1024, 1024, 1024, 0, 0}; S.init(MT, 2 * DFF, G, (int)blockIdx.x);
        pg8::EpiSwiGLU E{H, SS}; pg8::gemm_phase(L3, g, S, E);
    } SEAM(2);
    if (IN(3)) REPS(3) { RSYNC();
        pg8::Gemm g{H, (const bf16_t*)(ws + WS_W1D), MT, 1024, DFF, DFF, DFF, 0, 0}; S.init(MT, 1024, G, (int)blockIdx.x);
        pg8::EpiRes<true> E{nullptr, nullptr, XB, 0.5f, nullptr, XB, SS + MT}; pg8::gemm_phase(L3, g, S, E, STAG_DOWN);
    } SEAM(3);
#else
    if (IN(2)) {
        phase_toeplitz(dob);
        for (int c = 0; c < FFN_CHUNKS; ++c) {
            const size_t r0 = (size_t)c * FFN_MC;
            { pg8::Gemm g{XB + r0 * DM, (const bf16_t*)(ws + WS_W1), FFN_MC, 2 * DFF, 1024, 1024, 1024, 0, 0}; S.init(FFN_MC, 2 * DFF, G, (int)blockIdx.x);
              pg8::EpiSwiGLU E{H, SS + r0}; pg8::gemm_phase(L3, g, S, E); }
            GSYNC();
            { pg8::Gemm g{H, (const bf16_t*)(ws + WS_W1D), FFN_MC, 1024, DFF, LDH, DFF, 0, 0}; S.init(FFN_MC, 1024, G, (int)blockIdx.x);
              pg8::EpiRes<true> E{nullptr, nullptr, XB + r0 * DM, 0.5f, nullptr, XB + r0 * DM, SS + MT + r0}; pg8::gemm_phase(L3, g, S, E, STAG_DOWN); }
            if (c + 1 < FFN_CHUNKS) GSYNC();
        }
    } SEAM(3);
#endif
    if (IN(4)) REPS(4) { RSYNC();
        pg8::Gemm g{XB, (const bf16_t*)(ws + WS_WIN), MT, 2048, 1024, 1024, 1024, 0, 0}; S.init(MT, 2048, G, (int)blockIdx.x);
        pg8::EpiProj E{SS + MT, (const f32x4*)(ws + WS_ROPE), (bf16_t*)(ws + WS_Q12), (bf16_t*)(ws + WS_K12), (bf16_t*)(ws + WS_V), (bf16_t*)(ws + WS_UH)}; pg8::gemm_phase(L3, g, S, E);
    } SEAM(4);
    if (IN(5)) REPS(5) { RSYNC();
        pg8::Gemm g{(const bf16_t*)(ws + WS_UH), (const bf16_t*)(dob + DO_WSM), MG, 256, 1024, LDU, 1024, 6, 1}; S.init(MG, 256, G, (int)blockIdx.x);
        pg8::EpiS E{(float*)(ws + WS_S)}; pg8::gemm_phase(L3, g, S, E);
    } SEAM(5);
    if (IN(6)) REPS(6) { RSYNC(); phase_chunkscan(ws, dob); phase_attn(a, ws, dob, (char*)lds); } SEAM(6);
    if (IN(7)) REPS(7) { RSYNC();
        pg8::Gemm g{(const bf16_t*)(ws + WS_UH), (const bf16_t*)(dob + DO_BTY), MG, 1024, LDU, LDU, LDU, 6, 4}; S.init(MG, 1024, G, (int)blockIdx.x);
        pg8::EpiY E{(bf16_t*)(ws + WS_Q12)}; pg8::gemm_phase(L3, g, S, E);
    } SEAM(7);
    if (IN(8)) REPS(8) { RSYNC();
        pg8::Gemm g{(const bf16_t*)(ws + WS_Q12), (const bf16_t*)(ws + WS_WGLU), MT, 512, 512, 512, 512, 0, 0}; S.init(MT, 512, G, (int)blockIdx.x);
        pg8::EpiGLU E{(const bf16_t*)(ws + WS_Q12), (bf16_t*)(dob + DO_MIX)}; pg8::gemm_phase(L3, g, S, E);
    } SEAM(8);
    if (IN(9)) REPS(9) { RSYNC();
        pg8::Gemm g{(const bf16_t*)(dob + DO_MIX), (const bf16_t*)(ws + WS_WOUT), MT, 1024, 1024, 1024, 1024, 0, 0}; S.init(MT, 1024, G, (int)blockIdx.x);
        pg8::EpiRes<true> E{nullptr, nullptr, XB, 1.0f, nullptr, XB, SS + 2 * MT}; pg8::gemm_phase(L3, g, S, E, STAG_OUT);
    } SEAM(9);
#if MK_MULTI
    if (IN(10)) REPS(10) { RSYNC();
        pg8::Gemm g{XB, (const bf16_t*)(ws + WS_W2), MT, 2 * DFF, 1024, 1024, 1024, 0, 0}; S.init(MT, 2 * DFF, G, (int)blockIdx.x);
        pg8::EpiSwiGLU E{H, SS + 2 * MT}; pg8::gemm_phase(L3, g, S, E);
    } SEAM(10);
    if (IN(11)) REPS(11) { RSYNC();
        pg8::Gemm g{H, (const bf16_t*)(ws + WS_W2D), MT, 1024, DFF, DFF, DFF, 0, 0}; S.init(MT, 1024, G, (int)blockIdx.x);
        pg8::EpiRes<true> E{nullptr, nullptr, XB, 0.5f, nullptr, XB, nullptr}; pg8::gemm_phase(L3, g, S, E, STAG_DOWN);
    } SEAM(11);
#else
    if (IN(10)) {
        for (int c = 0; c < FFN_CHUNKS; ++c) {
            const size_t r0 = (size_t)c * FFN_MC;
            { pg8::Gemm g{XB + r0 * DM, (const bf16_t*)(ws + WS_W2), FFN_MC, 2 * DFF, 1024, 1024, 1024, 0, 0}; S.init(FFN_MC, 2 * DFF, G, (int)blockIdx.x);
              pg8::EpiSwiGLU E{H, SS + 2 * MT + r0}; pg8::gemm_phase(L3, g, S, E); }
            GSYNC();
            { pg8::Gemm g{H, (const bf16_t*)(ws + WS_W2D), FFN_MC, 1024, DFF, LDH, DFF, 0, 0}; S.init(FFN_MC, 1024, G, (int)blockIdx.x);
              pg8::EpiRes<true> E{nullptr, nullptr, XB + r0 * DM, 0.5f, nullptr, XB + r0 * DM, nullptr}; pg8::gemm_phase(L3, g, S, E, STAG_DOWN); }
            if (c + 1 < FFN_CHUNKS) GSYNC();
        }
    } SEAM(11);
#endif
    if (IN(12)) { phase_final(a, XB); }
#undef IN
#undef SEAM
}

extern "C" void kernel_launch(void* const* d_in, const int* in_sizes, int n_in, void* d_out, int out_size, void* d_ws, size_t ws_size, hipStream_t stream) {
    static int grid = 0;
    if (grid == 0) {
        if (n_in != 28 || in_sizes[0] != MP * DM || out_size != MT * DM || ws_size < WS_END) { fprintf(stderr, "kernel_launch: unexpected shapes n_in %d in0 %d out %d ws %zu\n", n_in, n_in > 0 ? in_sizes[0] : -1, out_size, ws_size); grid = -1; return; }
        int dev = 0, cus = 0, per_cu = 0;
        hipGetDevice(&dev); hipDeviceGetAttribute(&cus, hipDeviceAttributeMultiprocessorCount, dev);
        if (hipFuncSetAttribute((const void*)fwd_kernel, hipFuncAttributeMaxDynamicSharedMemorySize, LDS_BYTES) != hipSuccess) { fprintf(stderr, "kernel_launch: hipFuncSetAttribute failed\n"); grid = -1; return; }
        if (hipOccupancyMaxActiveBlocksPerMultiprocessor(&per_cu, (const void*)fwd_kernel, NTHR, LDS_BYTES) != hipSuccess || per_cu < 1) { fprintf(stderr, "kernel_launch: occupancy query says %d\n", per_cu); per_cu = 1; }
        (void)hipGetLastError();
        grid = cus * 1;
    }
    if (grid < 0) return;
    Args a{};
    for (int i = 0; i < 28; ++i) a.in[i] = (const float*)d_in[i];
    a.out = (float*)d_out; a.ws = (unsigned char*)d_ws;
#if MK_MULTI
    for (int p = 0; p < NPHASE; ++p) { a.ph_lo = p; a.ph_hi = p + 1; hipLaunchKernelGGL(fwd_kernel, dim3(grid), dim3(NTHR), LDS_BYTES, stream, a); }
#else
    a.ph_lo = 0; a.ph_hi = NPHASE;
    if (hipMemsetAsync((char*)d_ws + WS_BAR, 0, 16384, stream) != hipSuccess) { fprintf(stderr, "kernel_launch: memset of the barrier words failed\n"); return; }
    void* args[] = {&a};
    hipError_t e = hipLaunchCooperativeKernel((const void*)fwd_kernel, dim3(grid), dim3(NTHR), args, LDS_BYTES, stream);
    if (e != hipSuccess) fprintf(stderr, "kernel_launch: cooperative launch failed: %s (grid %d)\n", hipGetErrorString(e), grid);
#endif
}
```
